# Optimizing an MI355X kernel written in HIP

```python
import math
import jax, jax.numpy as jnp
from jax import lax
import numpy as np

D_MODEL = 1024
BATCH = 8
SEQ = 4096
DEPTH = 2

HEAD_DIM = 64
A_HEADS = 6
A_NOPE = 64
A_ROPE = 32
A_V = 64
Q_LORA = 768
KV_LORA = 256
ROPE_THETA = 10000.0
B_HEADS = 6
DILATED_PATTERNS = ((128, 1), (512, 4), (2048, 16))
C_HEADS = 4
IDX_HEADS = 8
IDX_DIM = 64
TOPK_MAX = 256
Q_BLOCK = 128

A_WIDTH = A_HEADS * A_V
B_WIDTH = B_HEADS * HEAD_DIM
C_WIDTH = C_HEADS * HEAD_DIM
MIX_WIDTH = A_WIDTH + B_WIDTH + C_WIDTH
N_ALIBI = B_HEADS + C_HEADS

SPLIT_SIZES = (Q_LORA, KV_LORA, A_ROPE,
               B_WIDTH, B_WIDTH, B_WIDTH,
               C_WIDTH, C_WIDTH, C_WIDTH,
               IDX_HEADS * IDX_DIM, IDX_DIM, IDX_HEADS,
               MIX_WIDTH)
IN_WIDTH = sum(SPLIT_SIZES)
SPLIT_POINTS = [int(v) for v in np.cumsum(SPLIT_SIZES)[:-1]]

ALPHA = (2 * DEPTH) ** 0.25
BETA = (8 * DEPTH) ** -0.25

kernel_name = "hybrid_mla_dilated_dsa_deepnorm"

F32 = jnp.float32


def layer_norm(x, g, b, eps=1e-5):
    xf = x.astype(F32)
    mu = jnp.mean(xf, axis=-1, keepdims=True)
    xc = xf - mu
    var = jnp.mean(xc * xc, axis=-1, keepdims=True)
    return (xc * lax.rsqrt(var + eps) * g.astype(F32) + b.astype(F32)).astype(x.dtype)


def rms_norm(x, g, eps=1e-6):
    xf = x.astype(F32)
    ms = jnp.mean(xf * xf, axis=-1, keepdims=True)
    return (xf * lax.rsqrt(ms + eps) * g.astype(F32)).astype(x.dtype)


def apply_rope(x, cos, sin):
    half = x.shape[-1] // 2
    x1, x2 = x[..., :half].astype(F32), x[..., half:].astype(F32)
    return jnp.concatenate([x1 * cos - x2 * sin, x1 * sin + x2 * cos], axis=-1).astype(x.dtype)


def alibi_slopes():
    return 2.0 ** (-8.0 * jnp.arange(1, N_ALIBI + 1, dtype=F32) / N_ALIBI)


def to_blocks(a):
    b, s = a.shape[0], a.shape[1]
    return a.reshape((b, s // Q_BLOCK, Q_BLOCK) + a.shape[2:]).swapaxes(0, 1)


def from_blocks(a):
    a = a.swapaxes(0, 1)
    return a.reshape((a.shape[0], a.shape[1] * a.shape[2]) + a.shape[3:])


def mla_attention(q_nope, q_rope, k_nope, k_rope, v):
    s_len = q_nope.shape[1]
    nb = s_len // Q_BLOCK
    scale = (A_NOPE + A_ROPE) ** -0.5
    key_pos = jnp.arange(s_len)

    def block(args):
        qn, qr, start = args
        qpos = start + jnp.arange(Q_BLOCK)
        s = (jnp.einsum('bqhd,bshd->bhqs', qn, k_nope, preferred_element_type=F32)
             + jnp.einsum('bqhr,bsr->bhqs', qr, k_rope, preferred_element_type=F32)) * scale
        s = jnp.where(key_pos[None, :] <= qpos[:, None], s, -jnp.inf)
        p = jax.nn.softmax(s, axis=-1)
        return jnp.einsum('bhqs,bshd->bqhd', p.astype(v.dtype), v)

    out = lax.map(block, (to_blocks(q_nope), to_blocks(q_rope), jnp.arange(nb) * Q_BLOCK))
    return from_blocks(out)


def dilated_attention(q, k, v, slopes):
    bsz, s_len, nh, dh = q.shape
    outs, lses = [], []
    for window, dil in DILATED_PATTERNS:
        n = window // dil
        L = s_len // dil
        nb = -(-L // n)
        Lp = nb * n

        def gather(a):
            a = a.reshape(bsz, L, dil, nh, dh).swapaxes(1, 2)
            a = jnp.pad(a, ((0, 0), (0, 0), (0, Lp - L), (0, 0), (0, 0)))
            return a.reshape(bsz, dil, nb, n, nh, dh)

        def band(a):
            prev = jnp.pad(a, ((0, 0), (0, 0), (1, 0), (0, 0), (0, 0), (0, 0)))[:, :, :-1]
            return jnp.concatenate([prev, a], axis=3)

        qb = gather(q)
        kb = band(gather(k))
        vb = band(gather(v))
        s = jnp.einsum('brnqhd,brnkhd->brnhqk', qb, kb, preferred_element_type=F32) * dh ** -0.5
        kj = jnp.arange(2 * n)
        step = jnp.arange(n)[:, None] + n - kj[None, :]
        valid = ((step >= 0) & (step <= n))[None] & ((jnp.arange(nb)[:, None, None] > 0) | (kj >= n)[None, None, :])
        s = s - slopes[:, None, None] * (step * dil).astype(F32)
        s = jnp.where(valid[:, None], s, -jnp.inf)
        m = jnp.max(s, axis=-1, keepdims=True)
        p = jnp.exp(s - m)
        den = jnp.sum(p, axis=-1, keepdims=True)
        o = jnp.einsum('brnhqk,brnkhd->brnqhd', (p / den).astype(v.dtype), vb)
        lse = (m + jnp.log(den))[..., 0].swapaxes(-1, -2)

        def ungather(a):
            tr = a.shape[4:]
            a = a.reshape((bsz, dil, Lp) + tr)[:, :, :L]
            return a.swapaxes(1, 2).reshape((bsz, s_len) + tr)

        outs.append(ungather(o))
        lses.append(ungather(lse))
    w = jax.nn.softmax(jnp.stack(lses, axis=0), axis=0)
    out = jnp.sum(w[..., None] * jnp.stack(outs, axis=0).astype(F32), axis=0)
    return out.astype(q.dtype)


def sparse_attention(q, k, v, q_idx, k_idx, w_idx, slopes):
    s_len, dh = q.shape[1], q.shape[3]
    topk = min(TOPK_MAX, s_len // 4)
    nb = s_len // Q_BLOCK
    key_pos = jnp.arange(s_len)
    take = jax.vmap(lambda a, i: a[i])

    def block(args):
        qb, qib, wb, start = args
        qpos = start + jnp.arange(Q_BLOCK)
        logits = jnp.einsum('bqhd,bsd->bqhs', qib, k_idx, preferred_element_type=F32) * IDX_DIM ** -0.5
        score = jnp.einsum('bqh,bqhs->bqs', wb.astype(F32) * IDX_HEADS ** -0.5, jax.nn.relu(logits))
        score = jnp.where(key_pos[None, None, :] <= qpos[None, :, None], score, -jnp.inf)
        _, idx = lax.top_k(score, topk)
        valid = idx <= qpos[None, :, None]
        kg = take(k, idx)
        vg = take(v, idx)
        s = jnp.einsum('bqhd,bqkhd->bhqk', qb, kg, preferred_element_type=F32) * dh ** -0.5
        dist = (qpos[None, :, None] - idx).astype(F32)
        s = s - slopes[None, :, None, None] * dist[:, None]
        s = jnp.where(valid[:, None], s, -jnp.inf)
        p = jax.nn.softmax(s, axis=-1)
        return jnp.einsum('bhqk,bqkhd->bqhd', p.astype(v.dtype), vg)

    out = lax.map(block, (to_blocks(q), to_blocks(q_idx), to_blocks(w_idx), jnp.arange(nb) * Q_BLOCK))
    return from_blocks(out)


def setup_inputs(seed: int = 0) -> dict:
    key = jax.random.key(seed)
    ks = jax.random.split(key, 14)
    nrm = jax.random.normal
    return {
        "x": nrm(ks[0], (BATCH, SEQ, D_MODEL), F32),
        "c": nrm(ks[1], (BATCH, D_MODEL), F32),
        "w_ada": nrm(ks[2], (DEPTH, D_MODEL, 3 * D_MODEL), F32) * (0.1 * D_MODEL ** -0.5),
        "b_ada": nrm(ks[3], (DEPTH, 3 * D_MODEL), F32) * 0.02,
        "w_in": nrm(ks[4], (DEPTH, D_MODEL, IN_WIDTH), F32) * D_MODEL ** -0.5,
        "q_norm_g": 1.0 + 0.02 * nrm(ks[5], (DEPTH, Q_LORA), F32),
        "kv_norm_g": 1.0 + 0.02 * nrm(ks[6], (DEPTH, KV_LORA), F32),
        "w_uq": nrm(ks[7], (DEPTH, Q_LORA, A_HEADS * (A_NOPE + A_ROPE)), F32) * Q_LORA ** -0.5,
        "w_uk": nrm(ks[8], (DEPTH, KV_LORA, A_HEADS * A_NOPE), F32) * KV_LORA ** -0.5,
        "w_uv": nrm(ks[9], (DEPTH, KV_LORA, A_HEADS * A_V), F32) * KV_LORA ** -0.5,
        "w_out": nrm(ks[10], (DEPTH, MIX_WIDTH, D_MODEL), F32) * (BETA * MIX_WIDTH ** -0.5),
        "ln_g": 1.0 + 0.02 * nrm(ks[11], (DEPTH, D_MODEL), F32),
        "ln_b": 0.02 * nrm(ks[12], (DEPTH, D_MODEL), F32),
    }


def reference(x, c, w_ada, b_ada, w_in, q_norm_g, kv_norm_g, w_uq, w_uk, w_uv, w_out, ln_g, ln_b):
    bsz, s_len, _ = x.shape
    slopes = alibi_slopes()
    slopes_b, slopes_c = slopes[:B_HEADS], slopes[B_HEADS:]
    pos = jnp.arange(s_len, dtype=F32)
    freqs = ROPE_THETA ** (-jnp.arange(0, A_ROPE, 2, dtype=F32) / A_ROPE)
    ang = pos[:, None] * freqs[None, :]
    cos, sin = jnp.cos(ang), jnp.sin(ang)

    def heads(a, n):
        return a.reshape(bsz, s_len, n, -1)

    for l in range(DEPTH):
        mod = jax.nn.silu(c) @ w_ada[l] + b_ada[l]
        shift, scale, gate = jnp.split(mod, 3, axis=-1)
        h = x * (1.0 + scale[:, None, :]) + shift[:, None, :]
        (p_cq, p_ckv, p_kr, p_qb, p_kb, p_vb, p_qc, p_kc, p_vc,
         p_qi, p_ki, p_wi, p_gate) = jnp.split(h @ w_in[l], SPLIT_POINTS, axis=-1)

        cq = rms_norm(p_cq, q_norm_g[l])
        ckv = rms_norm(p_ckv, kv_norm_g[l])
        qa = heads(cq @ w_uq[l], A_HEADS)
        qa_nope = qa[..., :A_NOPE]
        qa_rope = apply_rope(qa[..., A_NOPE:], cos[:, None, :], sin[:, None, :])
        ka_nope = heads(ckv @ w_uk[l], A_HEADS)
        va = heads(ckv @ w_uv[l], A_HEADS)
        ka_rope = apply_rope(p_kr, cos, sin)
        o_a = mla_attention(qa_nope, qa_rope, ka_nope, ka_rope, va)

        o_b = dilated_attention(heads(p_qb, B_HEADS), heads(p_kb, B_HEADS), heads(p_vb, B_HEADS), slopes_b)

        o_c = sparse_attention(heads(p_qc, C_HEADS), heads(p_kc, C_HEADS), heads(p_vc, C_HEADS),
                               heads(p_qi, IDX_HEADS), p_ki, p_wi, slopes_c)

        y = jnp.concatenate([o_a.reshape(bsz, s_len, A_WIDTH),
                             o_b.reshape(bsz, s_len, B_WIDTH),
                             o_c.reshape(bsz, s_len, C_WIDTH)], axis=-1) * jax.nn.silu(p_gate)
        sub = y @ w_out[l]
        x = layer_norm(ALPHA * x + (1.0 + gate[:, None, :]) * sub, ln_g[l], ln_b[l])
    return x
```

```cpp
#include <hip/hip_runtime.h>
#include <cstdio>
#include <cstdint>

#define LAS __attribute__((address_space(3)))
typedef unsigned short bf16_t;
typedef short bf16x8 __attribute__((ext_vector_type(8)));
typedef float f32x4 __attribute__((ext_vector_type(4)));
typedef unsigned u32x4 __attribute__((ext_vector_type(4)));
typedef unsigned long long u64;

constexpr int NB = 8, SEQ = 4096, DM = 1024, T = NB * SEQ, DEPTH = 2;
constexpr int INW = 4584, NIN = 4608;
constexpr int LD_PA = 1024, LD_PB = 1280, LD_PC = 768, LD_PI = 512, LD_PG = 1024;
constexpr int PB_QB = 0, PB_KB = 384, PB_VB = 768, PB_KR = 1152, PB_KI = 1184, PB_WI = 1248;
constexpr int LD_QA = 576, LD_KA = 576, LD_VA = 384;
constexpr float LOG2E = 1.4426950408889634f;
constexpr float QSC64 = 0.125f * LOG2E;
constexpr float QSC96 = 0.10206207261596575f * LOG2E;
constexpr float ALPHA = 1.4142135623730951f;

constexpr size_t MiB = 1u << 20;
constexpr size_t WS_CTL = 0;
constexpr size_t WS_MOD = 1 * MiB;
constexpr size_t WS_ROPE = 1 * MiB + 256 * 1024;
constexpr size_t WS_RST = 1 * MiB + 768 * 1024;
constexpr size_t WS_WIN = 2 * MiB;
constexpr size_t WS_WUQ = 20 * MiB;
constexpr size_t WS_WUKV = 23 * MiB;
constexpr size_t WS_WOUT = 24 * MiB;
constexpr size_t WS_H = 28 * MiB;
constexpr size_t WS_QA = 28 * MiB, WS_VA = 64 * MiB;
constexpr size_t WS_PA = 92 * MiB;
constexpr size_t WS_Y = 92 * MiB;
constexpr size_t WS_PB = 156 * MiB;
constexpr size_t WS_PC = 236 * MiB;
constexpr size_t WS_PI = 284 * MiB;
constexpr size_t WS_PG = 316 * MiB;
constexpr size_t WS_KA = 380 * MiB;
constexpr size_t WS_MASK = 416 * MiB;
constexpr size_t WS_PART = 432 * MiB;
constexpr size_t WS_END = 507 * MiB;

__device__ __forceinline__ float bf2f(unsigned u) { return __uint_as_float(u << 16); }
__device__ __forceinline__ unsigned f2bf(float f) { unsigned u = __float_as_uint(f); return (u + 0x7fffu + ((u >> 16) & 1u)) >> 16; }
__device__ __forceinline__ unsigned pk2(float lo, float hi) { return f2bf(lo) | (f2bf(hi) << 16); }
__device__ __forceinline__ float silu(float x) { return x / (1.0f + __expf(-x)); }
__device__ __forceinline__ float wave_sum(float v) {
#pragma unroll
    for (int o = 1; o < 64; o <<= 1) v += __shfl_xor(v, o);
    return v;
}
__device__ __forceinline__ float wave_max(float v) {
#pragma unroll
    for (int o = 1; o < 64; o <<= 1) v = fmaxf(v, __shfl_xor(v, o));
    return v;
}
__device__ __forceinline__ int wave_sum_i(int v) {
#pragma unroll
    for (int o = 1; o < 64; o <<= 1) v += __shfl_xor(v, o);
    return v;
}
__device__ __forceinline__ void unpack8(const u32x4 v, float* f) {
    f[0] = bf2f(v.x & 0xffffu); f[1] = __uint_as_float(v.x & 0xffff0000u);
    f[2] = bf2f(v.y & 0xffffu); f[3] = __uint_as_float(v.y & 0xffff0000u);
    f[4] = bf2f(v.z & 0xffffu); f[5] = __uint_as_float(v.z & 0xffff0000u);
    f[6] = bf2f(v.w & 0xffffu); f[7] = __uint_as_float(v.w & 0xffff0000u);
}

namespace pg8 {
constexpr int BM = 256, BK = 64, HALF = 128, HTB = HALF * BK * 2, STAGE_BYTES = 8 * HTB, NXCD = 8, WGM = 8;
__host__ __device__ __forceinline__ int lds_byte(int r, int c) { const int st = (r >> 4) * 2 + (c >> 5), rr = r & 15, cc = c & 31, ob = rr * 64 + cc * 2; return st * 1024 + (ob ^ (((ob >> 9) & 1) << 5)); }
__host__ __device__ __forceinline__ void stage_rc(int b, int& R, int& C) { const int st = b / 1024, sb = b % 1024, swz = sb ^ (((sb >> 9) & 1) << 5); R = (st >> 1) * 16 + swz / 64; C = (st & 1) * 32 + (swz % 64) / 2; }
__host__ __device__ __forceinline__ int perm32(int rho) { const int n = rho >> 4, i = rho & 15; return 8 * (i >> 2) + 4 * n + (i & 3); }

struct Unit { int pm, pn; };
struct Gemm { const bf16_t* A; const bf16_t* Bt; int M, N, K, lda, ldb; };

struct StaticOrder {
    int nM, nN, nwg, G, c;
    __host__ __device__ void init(int M, int N, int G_, int c_) { nM = M / BM; nN = N / BM; nwg = nM * nN; G = G_; c = c_; }
    __host__ __device__ bool next(int i, Unit& u) const {
        const long L = (long)i * G + c; if (L >= nwg) return false;
        int wgid = (int)L; { const int q = nwg / NXCD, r = nwg % NXCD, xcd = wgid % NXCD, off = wgid / NXCD; wgid = (xcd < r ? xcd * (q + 1) : r * (q + 1) + (xcd - r) * q) + off; }
        const int nig = WGM * nN, gid = wgid / nig, fm = gid * WGM, gsz = (nM - fm) < WGM ? (nM - fm) : WGM;
        u.pm = fm + ((wgid % nig) % gsz); u.pn = (wgid % nig) / gsz; return true;
    }
};

template <class F> struct EpiChunk {
    static constexpr bool PERM = true;
    F f;
    __device__ __forceinline__ void operator()(const f32x4 (&acc)[2][2][4][2], const Unit& u, int wr, int wc, int fr, int fq) const {
        const int row0 = u.pm * BM + wr * 64 + fr, col0 = u.pn * BM + wc * 32 + 8 * fq;
#pragma unroll
        for (int ai = 0; ai < 2; ++ai)
#pragma unroll
            for (int m = 0; m < 4; ++m)
#pragma unroll
                for (int bj = 0; bj < 2; ++bj) f(row0 + ai * HALF + m * 16, col0 + bj * HALF, acc[ai][bj][m][0], acc[ai][bj][m][1]);
    }
};

template <class Epi, class Sched, bool ALIGN_EPI>
__device__ __forceinline__ void gemm_phase(LAS unsigned char* lds, const Gemm g, const Sched& S, const Epi& E) {
    const int tid = threadIdx.x, wid = __builtin_amdgcn_readfirstlane(tid >> 6), lane = tid & 63, wr = wid >> 2, wc = wid & 3, fr = lane & 15, fq = lane >> 4;
    const int K = g.K, nt = K / BK;
    unsigned voffA[2], voffB[2];
#pragma unroll
    for (int i = 0; i < 2; ++i) { int R, C; stage_rc(tid * 16 + i * 8192, R, C); const int Rb = Epi::PERM ? ((R & ~31) + perm32(R & 31)) : R;
        voffA[i] = (unsigned)(R * g.lda + C) * 2u; voffB[i] = (unsigned)(Rb * g.ldb + C) * 2u; }
    const size_t kstep = (size_t)(BK * 2);
    const size_t hsA = (size_t)HALF * g.lda * 2, hsB = (size_t)HALF * g.ldb * 2;
    const size_t tsA = 2 * hsA, tsB = 2 * hsB;
    const unsigned ldsw = (unsigned)wid * 1024u;
    const int aoff = lds_byte(wr * 64 + fr, fq * 8), boff = lds_byte(wc * 32 + fr, fq * 8);
#define PG8_SA(b, h) (((b) * 2 + (h)) * HTB)
#define PG8_SB(b, h) ((4 + (b) * 2 + (h)) * HTB)
#define PG8_STAGE(bufoff, gbase, voff) do { _Pragma("unroll") for (int _i = 0; _i < 2; ++_i) \
        __builtin_amdgcn_global_load_lds((const unsigned*)((const char*)(gbase) + (voff)[_i]), (LAS unsigned*)(lds + (bufoff) + ldsw + _i * 8192), 16, 0, 0); } while (0)
#define PG8_LDA(dst, b, h) do { _Pragma("unroll") for (int m = 0; m < 4; ++m) _Pragma("unroll") for (int k = 0; k < 2; ++k) dst[m][k] = *(const LAS bf16x8*)(lds + PG8_SA(b, h) + aoff + m * 2048 + k * 1024); } while (0)
#define PG8_LDB(dst, b, h) do { _Pragma("unroll") for (int n = 0; n < 2; ++n) _Pragma("unroll") for (int k = 0; k < 2; ++k) dst[n][k] = *(const LAS bf16x8*)(lds + PG8_SB(b, h) + boff + n * 2048 + k * 1024); } while (0)
#define PG8_MMA(ai, bj, At, Bt) do { __builtin_amdgcn_s_setprio(1); _Pragma("unroll") for (int m = 0; m < 4; ++m) _Pragma("unroll") for (int n = 0; n < 2; ++n) _Pragma("unroll") for (int k = 0; k < 2; ++k) \
        acc[ai][bj][m][n] = __builtin_amdgcn_mfma_f32_16x16x32_bf16(Bt[n][k], At[m][k], acc[ai][bj][m][n], 0, 0, 0); __builtin_amdgcn_s_setprio(0); } while (0)
#define PG8_WAIT_V(n) asm volatile("s_waitcnt vmcnt(" #n ")" ::: "memory")
#define PG8_WAIT_L(n) asm volatile("s_waitcnt lgkmcnt(" #n ")" ::: "memory")
#define PG8_BAR __builtin_amdgcn_s_barrier()
#define PG8_SCHED __builtin_amdgcn_sched_barrier(0)
    Unit cur, nxt; int ui = 0;
    if (!S.next(0, cur)) return;
    f32x4 acc[2][2][4][2];
#pragma unroll
    for (int a = 0; a < 2; ++a)
#pragma unroll
        for (int b = 0; b < 2; ++b)
#pragma unroll
            for (int m = 0; m < 4; ++m)
#pragma unroll
                for (int n = 0; n < 2; ++n) acc[a][b][m][n] = (f32x4){0.f, 0.f, 0.f, 0.f};
    bf16x8 At[4][2], B0[2][2], B1[2][2];
    const char* cA = (const char*)g.A + (size_t)cur.pm * tsA; const char* cB = (const char*)g.Bt + (size_t)cur.pn * tsB;
    PG8_STAGE(PG8_SB(0, 0), cB, voffB); PG8_STAGE(PG8_SB(0, 1), cB + hsB, voffB); PG8_STAGE(PG8_SA(0, 0), cA, voffA); PG8_STAGE(PG8_SA(0, 1), cA + hsA, voffA);
    if (wr == 1) PG8_BAR;
    PG8_WAIT_V(2); PG8_BAR;
    PG8_STAGE(PG8_SB(1, 0), cB + kstep, voffB); PG8_STAGE(PG8_SA(1, 0), cA + kstep, voffA); PG8_STAGE(PG8_SB(1, 1), cB + hsB + kstep, voffB);
    PG8_WAIT_V(6); PG8_BAR;
    for (;;) {
        const bool has_next = S.next(ui + 1, nxt);
        const char* nA = has_next ? (const char*)g.A + (size_t)nxt.pm * tsA : cA; const char* nB = has_next ? (const char*)g.Bt + (size_t)nxt.pn * tsB : cB;
        for (int t = 0; t < nt; t += 2) {
            const bool last = (t == nt - 2);
            const char* a1 = cA + (size_t)(t + 1) * kstep;
            const char* a2 = last ? nA : cA + (size_t)(t + 2) * kstep; const char* b2 = last ? nB : cB + (size_t)(t + 2) * kstep;
            const char* a3 = a2 + kstep; const char* b3 = b2 + kstep;
            PG8_LDB(B0, 0, 0); PG8_LDB(B1, 0, 1); PG8_SCHED; PG8_LDA(At, 0, 0); PG8_STAGE(PG8_SA(1, 1), a1 + hsA, voffA);
            PG8_WAIT_V(8); PG8_WAIT_L(0); PG8_BAR; PG8_MMA(0, 0, At, B0); PG8_MMA(0, 1, At, B1); PG8_BAR; PG8_SCHED;
            PG8_LDA(At, 0, 1); PG8_STAGE(PG8_SB(0, 0), b2, voffB); PG8_STAGE(PG8_SB(0, 1), b2 + hsB, voffB); PG8_STAGE(PG8_SA(0, 0), a2, voffA);
            PG8_WAIT_V(8); PG8_WAIT_L(0); PG8_BAR; PG8_MMA(1, 0, At, B0); PG8_MMA(1, 1, At, B1); PG8_BAR; PG8_SCHED;
            PG8_LDB(B0, 1, 0); PG8_LDB(B1, 1, 1); PG8_SCHED; PG8_LDA(At, 1, 0); PG8_STAGE(PG8_SA(0, 1), a2 + hsA, voffA);
            PG8_WAIT_V(8); PG8_WAIT_L(0); PG8_BAR; PG8_MMA(0, 0, At, B0); PG8_MMA(0, 1, At, B1); PG8_BAR; PG8_SCHED;
            PG8_LDA(At, 1, 1); PG8_STAGE(PG8_SB(1, 0), b3, voffB); PG8_STAGE(PG8_SB(1, 1), b3 + hsB, voffB); PG8_STAGE(PG8_SA(1, 0), a3, voffA);
            PG8_WAIT_V(8); PG8_WAIT_L(0); PG8_BAR; PG8_MMA(1, 0, At, B0); PG8_MMA(1, 1, At, B1); PG8_BAR; PG8_SCHED;
        }
        if constexpr (ALIGN_EPI) { if (wr == 0) PG8_BAR; }
        E(acc, cur, wr, wc, fr, fq);
        if (!has_next) break;
#pragma unroll
        for (int a = 0; a < 2; ++a)
#pragma unroll
            for (int b = 0; b < 2; ++b)
#pragma unroll
                for (int m = 0; m < 4; ++m)
#pragma unroll
                    for (int n = 0; n < 2; ++n) acc[a][b][m][n] = (f32x4){0.f, 0.f, 0.f, 0.f};
        cur = nxt; cA = nA; cB = nB; ++ui;
        if constexpr (ALIGN_EPI) { if (wr == 1) PG8_BAR; }
    }
    PG8_WAIT_V(0);
    if constexpr (!ALIGN_EPI) { if (wr == 0) PG8_BAR; }
    PG8_BAR;
#undef PG8_SA
#undef PG8_SB
#undef PG8_STAGE
#undef PG8_LDA
#undef PG8_LDB
#undef PG8_MMA
#undef PG8_WAIT_V
#undef PG8_WAIT_L
#undef PG8_BAR
#undef PG8_SCHED
}
}

struct Params {
    const float* x; const float* c; const float* w_ada; const float* b_ada; const float* w_in; const float* qg; const float* kvg;
    const float* w_uq; const float* w_uk; const float* w_uv; const float* w_out; const float* ln_g; const float* ln_b;
    float* out; unsigned char* ws; int layer; int pad;
};

__device__ __forceinline__ int map_in(int n, float& sc) {
    sc = 1.f;
    if (n < 1024) return n;
    if (n < 2304) { const int j = n - 1024;
        if (j < 384) { sc = QSC64; return 1056 + j; }
        if (j < 768) return 1440 + (j - 384);
        if (j < 1152) return 1824 + (j - 768);
        if (j < 1184) { const int w = j - 1152; return 1024 + (w >> 1) + 16 * (w & 1); }
        if (j < 1248) return 3488 + (j - 1184);
        if (j < 1256) return 3552 + (j - 1248);
        return -1; }
    if (n < 3072) { const int j = n - 2304; if (j < 256) sc = QSC64; return 2208 + j; }
    if (n < 3584) return 2976 + (n - 3072);
    return 3560 + (n - 3584);
}
__device__ __forceinline__ void prep_tile(const Params& p, int tile, float (*tl)[33]) {
    const int tid = threadIdx.x;
    constexpr int TIN = 144 * 16, TUQ = 24 * 12, TUKV = 24 * 4, TOUT = 32 * 16, TL = TIN + TUQ + TUKV + TOUT;
    const int l = tile / TL; int r = tile % TL;
    int kind, K, nkb;
    if (r < TIN) { kind = 0; K = 1024; } else if ((r -= TIN) < TUQ) { kind = 1; K = 768; } else if ((r -= TUQ) < TUKV) { kind = 2; K = 256; } else { r -= TUKV; kind = 3; K = 1024; }
    nkb = K / 64; const int n0 = (r / nkb) * 32, k0 = (r % nkb) * 64;
    const int i = tid & 31, j = tid >> 5, n = n0 + i;
    const float* src = nullptr; int srcN = 0, scol = -1; float cs = 1.f; const float* ks = nullptr; bf16_t* dst = nullptr;
    if (kind == 0) { src = p.w_in + (size_t)l * 1024 * INW; srcN = INW; scol = map_in(n, cs); dst = (bf16_t*)(p.ws + WS_WIN) + (size_t)l * NIN * 1024; }
    else if (kind == 1) { src = p.w_uq + (size_t)l * 768 * 576; srcN = 576; ks = p.qg + l * 768; cs = QSC96; dst = (bf16_t*)(p.ws + WS_WUQ) + (size_t)l * 768 * 768;
        if (n < 576) { const int h = n / 96, w = n % 96; scol = (w < 64) ? 96 * h + w : 96 * h + 64 + ((w - 64) >> 1) + 16 * ((w - 64) & 1); } }
    else if (kind == 2) { ks = p.kvg + l * 256; dst = (bf16_t*)(p.ws + WS_WUKV) + (size_t)l * 768 * 256; srcN = 384;
        if (n < 384) { src = p.w_uk + (size_t)l * 256 * 384; scol = n; } else { src = p.w_uv + (size_t)l * 256 * 384; scol = n - 384; } }
    else { src = p.w_out + (size_t)l * 1024 * 1024; srcN = 1024; scol = n; dst = (bf16_t*)(p.ws + WS_WOUT) + (size_t)l * 1024 * 1024; }
#pragma unroll
    for (int kk = j; kk < 64; kk += 8) { const int k = k0 + kk; float v = 0.f; if (scol >= 0) { v = src[(size_t)k * srcN + scol] * cs; if (ks) v *= ks[k]; } tl[kk][i] = v; }
    __syncthreads();
    { const int nn = tid >> 3, kc = tid & 7; u32x4 o;
      o.x = pk2(tl[kc * 8 + 0][nn], tl[kc * 8 + 1][nn]); o.y = pk2(tl[kc * 8 + 2][nn], tl[kc * 8 + 3][nn]);
      o.z = pk2(tl[kc * 8 + 4][nn], tl[kc * 8 + 5][nn]); o.w = pk2(tl[kc * 8 + 6][nn], tl[kc * 8 + 7][nn]);
      *(u32x4*)(dst + (size_t)(n0 + nn) * K + k0 + kc * 8) = o; }
    __syncthreads();
}
constexpr int PREP_TILES = 2 * (144 * 16 + 24 * 12 + 24 * 4 + 32 * 16);
__global__ void __launch_bounds__(256) k_prep(Params p) {
    __shared__ float tl[64][33];
    for (int t = blockIdx.x; t < PREP_TILES; t += gridDim.x) prep_tile(p, t, tl);
}
__global__ void __launch_bounds__(256) k_mod(Params p) {
    __shared__ float sc[NB][1024];
    const int l = blockIdx.x / 12, j = (blockIdx.x % 12) * 256 + threadIdx.x;
    for (int e = threadIdx.x; e < NB * 1024; e += 256) sc[e >> 10][e & 1023] = silu(p.c[e]);
    __syncthreads();
    float acc[NB];
#pragma unroll
    for (int b = 0; b < NB; ++b) acc[b] = 0.f;
    const float* w = p.w_ada + (size_t)l * 1024 * 3072 + j;
    for (int k = 0; k < 1024; ++k) { const float wv = w[(size_t)k * 3072];
#pragma unroll
        for (int b = 0; b < NB; ++b) acc[b] += sc[b][k] * wv; }
    float* mod = (float*)(p.ws + WS_MOD) + (size_t)l * NB * 3072;
    const float bias = p.b_ada[l * 3072 + j];
#pragma unroll
    for (int b = 0; b < NB; ++b) mod[b * 3072 + j] = acc[b] + bias;
}
__device__ __forceinline__ void rope_entry(int pos, int i, float& c, float& s) {
    const float th = exp2f(-(float)i * (13.287712379549449f / 16.0f));
    const float angf = (float)pos * th;
    const double a = (double)angf, n = rint(a * 0.15915494309189535), r = (a - n * 6.283185307179586) - n * 2.4492935982947064e-16;
    const double r2 = r * r; double sn = 0.0, cs = 0.0;
    double ts = r, tc = 1.0;
#pragma unroll
    for (int k = 0; k < 14; ++k) { sn += ts; cs += tc; tc = -tc * r2 / (double)((2 * k + 1) * (2 * k + 2)); ts = -ts * r2 / (double)((2 * k + 2) * (2 * k + 3)); }
    c = (float)cs; s = (float)sn;
}
__global__ void __launch_bounds__(256) k_rope(Params p) {
    const int e = blockIdx.x * 256 + threadIdx.x; if (e >= SEQ * 16) return;
    float c, s; rope_entry(e >> 4, e & 15, c, s);
    float* tab = (float*)(p.ws + WS_ROPE); tab[2 * e] = c; tab[2 * e + 1] = s;
}
__global__ void __launch_bounds__(256) k_makeh(Params p, const float* src) {
    const size_t e = ((size_t)blockIdx.x * 256 + threadIdx.x) * 8; if (e >= (size_t)T * DM) return;
    const int m = (int)(e >> 10), k = (int)(e & 1023), b = m / SEQ;
    const float* mod = (const float*)(p.ws + WS_MOD) + ((size_t)p.layer * NB + b) * 3072;
    const f32x4 x0 = *(const f32x4*)(src + e), x1 = *(const f32x4*)(src + e + 4);
    const f32x4 sh0 = *(const f32x4*)(mod + k), sh1 = *(const f32x4*)(mod + k + 4), s0 = *(const f32x4*)(mod + 1024 + k), s1 = *(const f32x4*)(mod + 1024 + k + 4);
    const f32x4 h0 = x0 * (s0 + 1.0f) + sh0, h1 = x1 * (s1 + 1.0f) + sh1;
    u32x4 o; o.x = pk2(h0.x, h0.y); o.y = pk2(h0.z, h0.w); o.z = pk2(h1.x, h1.y); o.w = pk2(h1.z, h1.w);
    *(u32x4*)((bf16_t*)(p.ws + WS_H) + e) = o;
}
__global__ void __launch_bounds__(256) k_rowstat(Params p) {
    const int m = blockIdx.x * 4 + (threadIdx.x >> 6), lane = threadIdx.x & 63;
    const bf16_t* row = (const bf16_t*)(p.ws + WS_PA) + (size_t)m * LD_PA;
    float f[8]; float sq = 0.f, skv = 0.f;
    unpack8(*(const u32x4*)(row + lane * 8), f);
#pragma unroll
    for (int e = 0; e < 8; ++e) sq += f[e] * f[e];
    unpack8(*(const u32x4*)(row + 512 + lane * 8), f);
    float s2 = 0.f;
#pragma unroll
    for (int e = 0; e < 8; ++e) s2 += f[e] * f[e];
    if (lane < 32) sq += s2; else skv += s2;
    sq = wave_sum(sq); skv = wave_sum(skv);
    if (lane == 0) { float* rs = (float*)(p.ws + WS_RST) + 2 * m; rs[0] = rsqrtf(sq * (1.0f / 768.0f) + 1e-6f); rs[1] = rsqrtf(skv * (1.0f / 256.0f) + 1e-6f); }
}
__global__ void __launch_bounds__(256) k_krope(Params p) {
    const int e = blockIdx.x * 256 + threadIdx.x; if (e >= T * 16) return;
    const int m = e >> 4, i = e & 15, pos = m % SEQ;
    const bf16_t* pb = (const bf16_t*)(p.ws + WS_PB) + (size_t)m * LD_PB + PB_KR;
    const unsigned pr = *(const unsigned*)(pb + 2 * i);
    const float x1 = bf2f(pr & 0xffffu), x2 = __uint_as_float(pr & 0xffff0000u);
    const float* tab = (const float*)(p.ws + WS_ROPE) + ((size_t)pos * 16 + i) * 2; const float c = tab[0], s = tab[1];
    const unsigned o = pk2(x1 * c - x2 * s, x1 * s + x2 * c);
    bf16_t* ka = (bf16_t*)(p.ws + WS_KA) + (size_t)m * LD_KA;
#pragma unroll
    for (int h = 0; h < 6; ++h) *(unsigned*)(ka + h * 96 + 64 + 2 * i) = o;
}

constexpr int GEMM_LDS = pg8::STAGE_BYTES;
struct FIn { unsigned char* ws;
    __device__ __forceinline__ void operator()(int row, int col, f32x4 v0, f32x4 v1) const {
        const int pn = col >> 8; bf16_t* base; int ld, c0;
        if (pn < 4) { base = (bf16_t*)(ws + WS_PA); ld = LD_PA; c0 = col; }
        else if (pn < 9) { base = (bf16_t*)(ws + WS_PB); ld = LD_PB; c0 = col - 1024; }
        else if (pn < 12) { base = (bf16_t*)(ws + WS_PC); ld = LD_PC; c0 = col - 2304; }
        else if (pn < 14) { base = (bf16_t*)(ws + WS_PI); ld = LD_PI; c0 = col - 3072; }
        else { base = (bf16_t*)(ws + WS_PG); ld = LD_PG; c0 = col - 3584; }
        u32x4 w; w.x = pk2(v0[0], v0[1]); w.y = pk2(v0[2], v0[3]); w.z = pk2(v1[0], v1[1]); w.w = pk2(v1[2], v1[3]);
        *(u32x4*)(base + (size_t)row * ld + c0) = w;
    }
};
struct FUq { unsigned char* ws;
    __device__ __forceinline__ void operator()(int row, int col, f32x4 v0, f32x4 v1) const {
        if (col >= 576) return;
        const float r = ((const float*)(ws + WS_RST))[2 * row];
        v0 = v0 * r; v1 = v1 * r;
        const int w = col % 96;
        if (w >= 64) { const int i0 = (w - 64) >> 1, pos = row % SEQ; const float* tab = (const float*)(ws + WS_ROPE) + ((size_t)pos * 16 + i0) * 2;
            const f32x4 t0 = *(const f32x4*)tab, t1 = *(const f32x4*)(tab + 4);
            f32x4 a, b;
            a[0] = v0[0] * t0[0] - v0[1] * t0[1]; a[1] = v0[0] * t0[1] + v0[1] * t0[0];
            a[2] = v0[2] * t0[2] - v0[3] * t0[3]; a[3] = v0[2] * t0[3] + v0[3] * t0[2];
            b[0] = v1[0] * t1[0] - v1[1] * t1[1]; b[1] = v1[0] * t1[1] + v1[1] * t1[0];
            b[2] = v1[2] * t1[2] - v1[3] * t1[3]; b[3] = v1[2] * t1[3] + v1[3] * t1[2];
            v0 = a; v1 = b; }
        u32x4 o; o.x = pk2(v0[0], v0[1]); o.y = pk2(v0[2], v0[3]); o.z = pk2(v1[0], v1[1]); o.w = pk2(v1[2], v1[3]);
        *(u32x4*)((bf16_t*)(ws + WS_QA) + (size_t)row * LD_QA + col) = o;
    }
};
struct FUkv { unsigned char* ws;
    __device__ __forceinline__ void operator()(int row, int col, f32x4 v0, f32x4 v1) const {
        const float r = ((const float*)(ws + WS_RST))[2 * row + 1];
        v0 = v0 * r; v1 = v1 * r;
        u32x4 o; o.x = pk2(v0[0], v0[1]); o.y = pk2(v0[2], v0[3]); o.z = pk2(v1[0], v1[1]); o.w = pk2(v1[2], v1[3]);
        if (col < 384) *(u32x4*)((bf16_t*)(ws + WS_KA) + (size_t)row * LD_KA + (col >> 6) * 96 + (col & 63)) = o;
        else *(u32x4*)((bf16_t*)(ws + WS_VA) + (size_t)row * LD_VA + (col - 384)) = o;
    }
};
struct FOut { const float* xin; float* out; const float* mod;
    __device__ __forceinline__ void operator()(int row, int col, f32x4 v0, f32x4 v1) const {
        const int b = row / SEQ; const float* g = mod + (size_t)b * 3072 + 2048 + col;
        const f32x4 g0 = *(const f32x4*)g, g1 = *(const f32x4*)(g + 4);
        const size_t off = (size_t)row * DM + col;
        const f32x4 x0 = *(const f32x4*)(xin + off), x1 = *(const f32x4*)(xin + off + 4);
        *(f32x4*)(out + off) = x0 * ALPHA + (g0 + 1.0f) * v0; *(f32x4*)(out + off + 4) = x1 * ALPHA + (g1 + 1.0f) * v1;
    }
};
template <int WHICH> __global__ void __launch_bounds__(512, 2) k_gemm(Params p) {
    extern __shared__ __attribute__((aligned(16))) unsigned char lds_raw[];
    LAS unsigned char* lds = (LAS unsigned char*)lds_raw;
    const int l = p.layer;
    pg8::StaticOrder S;
    if constexpr (WHICH == 0) {
        pg8::Gemm g{(const bf16_t*)(p.ws + WS_H), (const bf16_t*)(p.ws + WS_WIN) + (size_t)l * NIN * 1024, T, NIN, 1024, 1024, 1024};
        S.init(T, NIN, gridDim.x, blockIdx.x); pg8::EpiChunk<FIn> E{FIn{p.ws}};
        pg8::gemm_phase<pg8::EpiChunk<FIn>, pg8::StaticOrder, true>(lds, g, S, E);
    } else if constexpr (WHICH == 1) {
        pg8::Gemm g{(const bf16_t*)(p.ws + WS_PA), (const bf16_t*)(p.ws + WS_WUQ) + (size_t)l * 768 * 768, T, 768, 768, LD_PA, 768};
        S.init(T, 768, gridDim.x, blockIdx.x); pg8::EpiChunk<FUq> E{FUq{p.ws}};
        pg8::gemm_phase<pg8::EpiChunk<FUq>, pg8::StaticOrder, true>(lds, g, S, E);
    } else if constexpr (WHICH == 2) {
        pg8::Gemm g{(const bf16_t*)(p.ws + WS_PA) + 768, (const bf16_t*)(p.ws + WS_WUKV) + (size_t)l * 768 * 256, T, 768, 256, LD_PA, 256};
        S.init(T, 768, gridDim.x, blockIdx.x); pg8::EpiChunk<FUkv> E{FUkv{p.ws}};
        pg8::gemm_phase<pg8::EpiChunk<FUkv>, pg8::StaticOrder, true>(lds, g, S, E);
    } else {
        pg8::Gemm g{(const bf16_t*)(p.ws + WS_Y), (const bf16_t*)(p.ws + WS_WOUT) + (size_t)l * 1024 * 1024, T, 1024, 1024, 1024, 1024};
        S.init(T, 1024, gridDim.x, blockIdx.x);
        pg8::EpiChunk<FOut> E{FOut{l == 0 ? p.x : p.out, p.out, (const float*)(p.ws + WS_MOD) + (size_t)l * NB * 3072}};
        pg8::gemm_phase<pg8::EpiChunk<FOut>, pg8::StaticOrder, true>(lds, g, S, E);
    }
}
__global__ void __launch_bounds__(256) k_ln(Params p) {
    const int m = blockIdx.x * 4 + (threadIdx.x >> 6), lane = threadIdx.x & 63, l = p.layer;
    float* row = p.out + (size_t)m * DM;
    f32x4 v[4]; float s = 0.f;
#pragma unroll
    for (int j = 0; j < 4; ++j) { v[j] = *(const f32x4*)(row + j * 256 + lane * 4); s += (v[j].x + v[j].y) + (v[j].z + v[j].w); }
    const float mean = wave_sum(s) * (1.0f / DM); float s2 = 0.f;
#pragma unroll
    for (int j = 0; j < 4; ++j) { v[j] = v[j] - mean; s2 += (v[j].x * v[j].x + v[j].y * v[j].y) + (v[j].z * v[j].z + v[j].w * v[j].w); }
    const float rstd = rsqrtf(wave_sum(s2) * (1.0f / DM) + 1e-5f);
    const float* g = p.ln_g + l * DM; const float* bb = p.ln_b + l * DM;
    const int b = m / SEQ; const float* mod = (const float*)(p.ws + WS_MOD) + ((size_t)(l + 1) * NB + b) * 3072;
#pragma unroll
    for (int j = 0; j < 4; ++j) { const int k = j * 256 + lane * 4;
        const f32x4 y = v[j] * rstd * *(const f32x4*)(g + k) + *(const f32x4*)(bb + k);
        *(f32x4*)(row + k) = y;
        if (l + 1 < DEPTH) { const f32x4 h = y * (*(const f32x4*)(mod + 1024 + k) + 1.0f) + *(const f32x4*)(mod + k);
            unsigned long long o = (unsigned long long)pk2(h.x, h.y) | ((unsigned long long)pk2(h.z, h.w) << 32);
            *(unsigned long long*)((bf16_t*)(p.ws + WS_H) + (size_t)m * DM + k) = o; } }
}

__device__ __forceinline__ float rdlane(float v, int l) { return __uint_as_float(__builtin_amdgcn_readlane(__float_as_uint(v), l)); }
__device__ __forceinline__ float alibi_slope(int i) { return exp2f(-0.8f * (float)i); }

__global__ void __launch_bounds__(256) k_mla_naive(Params p) {
    __shared__ float qs[4][96];
    const int w = threadIdx.x >> 6, lane = threadIdx.x & 63;
    const int qi = blockIdx.x * 4 + w; const int t = qi % SEQ, h = (qi / SEQ) % 6, b = qi / (SEQ * 6);
    const size_t m = (size_t)b * SEQ + t;
    const bf16_t* QA = (const bf16_t*)(p.ws + WS_QA); const bf16_t* KA = (const bf16_t*)(p.ws + WS_KA); const bf16_t* VA = (const bf16_t*)(p.ws + WS_VA);
    for (int e = lane; e < 96; e += 64) qs[w][e] = bf2f(QA[m * LD_QA + h * 96 + e]);
    __syncthreads();
    float mx = -INFINITY, l = 0.f, o = 0.f;
    for (int c0 = 0; c0 <= t; c0 += 64) {
        const int s = c0 + lane; const bool valid = s <= t; float dot = -INFINITY;
        if (valid) { const bf16_t* kr = KA + ((size_t)b * SEQ + s) * LD_KA + h * 96; dot = 0.f;
#pragma unroll
            for (int c = 0; c < 12; ++c) { float f[8]; unpack8(*(const u32x4*)(kr + c * 8), f);
#pragma unroll
                for (int e = 0; e < 8; ++e) dot += f[e] * qs[w][c * 8 + e]; } }
        const float cm = wave_max(dot), mn = fmaxf(mx, cm), al = exp2f(mx - mn), pv = valid ? exp2f(dot - mn) : 0.f;
        l = l * al + wave_sum(pv); o *= al; mx = mn;
        const int nk = min(64, t - c0 + 1);
        for (int j = 0; j < nk; ++j) { const float pj = rdlane(pv, j); o += pj * bf2f(VA[((size_t)b * SEQ + c0 + j) * LD_VA + h * 64 + lane]); }
    }
    const int col = h * 64 + lane;
    const float g = bf2f(((const bf16_t*)(p.ws + WS_PG))[m * LD_PG + col]);
    ((bf16_t*)(p.ws + WS_Y))[m * DM + col] = (bf16_t)f2bf(o / l * silu(g));
}
__global__ void __launch_bounds__(256) k_dil_naive(Params p) {
    __shared__ float qs[4][64];
    const int w = threadIdx.x >> 6, lane = threadIdx.x & 63;
    const int qi = blockIdx.x * 4 + w; const int t = qi % SEQ, h = (qi / SEQ) % 6, b = qi / (SEQ * 6);
    const size_t m = (size_t)b * SEQ + t;
    const bf16_t* PB = (const bf16_t*)(p.ws + WS_PB);
    qs[w][lane] = bf2f(PB[m * LD_PB + PB_QB + h * 64 + lane]);
    __syncthreads();
    const float sl2 = alibi_slope(h + 1) * LOG2E;
    float mx = -INFINITY, l = 0.f, o = 0.f;
    for (int c0 = 0; c0 < 387; c0 += 64) {
        const int e = c0 + lane; const int pat = e / 129, j = e % 129, d = (pat == 0) ? 1 : (pat == 1) ? 4 : 16; const int s = t - j * d;
        const bool valid = (e < 387) && (s >= 0); float dot = -INFINITY;
        if (valid) { const bf16_t* kr = PB + ((size_t)b * SEQ + s) * LD_PB + PB_KB + h * 64; dot = 0.f;
#pragma unroll
            for (int c = 0; c < 8; ++c) { float f[8]; unpack8(*(const u32x4*)(kr + c * 8), f);
#pragma unroll
                for (int ee = 0; ee < 8; ++ee) dot += f[ee] * qs[w][c * 8 + ee]; }
            dot -= sl2 * (float)(j * d); }
        const float cm = wave_max(dot), mn = fmaxf(mx, cm), al = exp2f(mx - mn), pv = valid ? exp2f(dot - mn) : 0.f;
        l = l * al + wave_sum(pv); o *= al; mx = mn;
        for (int jj = 0; jj < 64; ++jj) { const float pj = rdlane(pv, jj); const int sj = __builtin_amdgcn_readlane(s, jj);
            if (pj != 0.f) o += pj * bf2f(PB[((size_t)b * SEQ + sj) * LD_PB + PB_VB + h * 64 + lane]); }
    }
    const int col = 384 + h * 64 + lane;
    const float g = bf2f(((const bf16_t*)(p.ws + WS_PG))[m * LD_PG + col]);
    ((bf16_t*)(p.ws + WS_Y))[m * DM + col] = (bf16_t)f2bf(o / l * silu(g));
}
__device__ __forceinline__ unsigned fkey(float f) { unsigned u = __float_as_uint(f); if (u == 0x80000000u) u = 0u; return (u & 0x80000000u) ? ~u : (u | 0x80000000u); }
__device__ __forceinline__ u64 select_row(const LAS float* sc, int lane) {
    unsigned u[64];
#pragma unroll
    for (int r = 0; r < 64; ++r) u[r] = fkey(sc[r * 64 + lane]);
    unsigned thr = 0u;
    for (int bit = 31; bit >= 0; --bit) {
        const unsigned cand = thr | (1u << bit); int c = 0;
#pragma unroll
        for (int r = 0; r < 64; ++r) c += (u[r] >= cand) ? 1 : 0;
        c = wave_sum_i(c);
        if (c >= 256) { thr = cand; if (c == 256) break; }
    }
    int cgt = 0;
#pragma unroll
    for (int r = 0; r < 64; ++r) cgt += (u[r] > thr) ? 1 : 0;
    cgt = wave_sum_i(cgt);
    int need = 256 - cgt, run = 0; u64 mine = 0ull;
    const u64 ltmask = (lane == 0) ? 0ull : (~0ull >> (64 - lane));
#pragma unroll
    for (int r = 0; r < 64; ++r) {
        const bool gt = u[r] > thr, eq = u[r] == thr;
        const u64 beq = __ballot(eq);
        const int pos = run + __popcll(beq & ltmask);
        const u64 word = __ballot(gt || (eq && pos < need));
        run += __popcll(beq);
        if (lane == r) mine = word;
    }
    return mine;
}
__global__ void __launch_bounds__(128) k_idx_naive(Params p) {
    __shared__ float sc[2][4096];
    __shared__ float qs[2][8][64];
    __shared__ float wsm[2][8];
    const int w = threadIdx.x >> 6, lane = threadIdx.x & 63;
    const int qi = blockIdx.x * 2 + w; const int t = qi % SEQ, b = qi / SEQ;
    const size_t m = (size_t)b * SEQ + t;
    u64* mrow = (u64*)(p.ws + WS_MASK) + m * 64;
    if (t < 256) {
        const int lo = lane * 64; u64 word = 0ull;
        if (t >= lo + 63) word = ~0ull; else if (t >= lo) word = (~0ull) >> (63 - (t - lo));
        mrow[lane] = word; return;
    }
    const bf16_t* PI = (const bf16_t*)(p.ws + WS_PI); const bf16_t* PB = (const bf16_t*)(p.ws + WS_PB);
    for (int e = lane; e < 512; e += 64) qs[w][e >> 6][e & 63] = bf2f(PI[m * LD_PI + e]);
    if (lane < 8) wsm[w][lane] = bf2f(PB[m * LD_PB + PB_WI + lane]);
    __builtin_amdgcn_s_waitcnt(0);
    for (int c0 = 0; c0 < 4096; c0 += 64) {
        const int s = c0 + lane; float score = -INFINITY;
        if (c0 <= t) {
            if (s <= t) { const bf16_t* kr = PB + ((size_t)b * SEQ + s) * LD_PB + PB_KI; float kf[64];
#pragma unroll
                for (int c = 0; c < 8; ++c) unpack8(*(const u32x4*)(kr + c * 8), kf + c * 8);
                score = 0.f;
#pragma unroll
                for (int hh = 0; hh < 8; ++hh) { float dot = 0.f;
#pragma unroll
                    for (int d = 0; d < 64; ++d) dot += kf[d] * qs[w][hh][d];
                    score += wsm[w][hh] * fmaxf(dot, 0.f); } }
        }
        sc[w][s] = score;
    }
    __builtin_amdgcn_s_waitcnt(0);
    const u64 word = select_row((const LAS float*)&sc[w][0], lane);
    mrow[lane] = word;
}
__global__ void __launch_bounds__(256) k_sparse_naive(Params p) {
    __shared__ int list[4][256];
    __shared__ float qs[4][64];
    const int w = threadIdx.x >> 6, lane = threadIdx.x & 63;
    const int qi = blockIdx.x * 4 + w; const int t = qi % SEQ, b = qi / SEQ;
    const size_t m = (size_t)b * SEQ + t;
    u64 word = ((const u64*)(p.ws + WS_MASK))[m * 64 + lane];
    int cnt = __popcll(word), off = cnt;
#pragma unroll
    for (int o = 1; o < 64; o <<= 1) { const int v = __shfl_up(off, o); if (lane >= o) off += v; }
    const int total = __builtin_amdgcn_readlane(off, 63); off -= cnt;
    while (word) { const int bpos = __builtin_ctzll(word); list[w][off++] = lane * 64 + bpos; word &= word - 1; }
    __builtin_amdgcn_s_waitcnt(0);
    const bf16_t* PC = (const bf16_t*)(p.ws + WS_PC);
    for (int h = 0; h < 4; ++h) {
        qs[w][lane] = bf2f(PC[m * LD_PC + h * 64 + lane]);
        __builtin_amdgcn_s_waitcnt(0);
        const float sl2 = alibi_slope(7 + h) * LOG2E;
        float mx = -INFINITY, l = 0.f, o = 0.f;
        for (int c0 = 0; c0 < total; c0 += 64) {
            const int e = c0 + lane; const bool valid = e < total; const int s = valid ? list[w][e] : 0; float dot = -INFINITY;
            if (valid) { const bf16_t* kr = PC + ((size_t)b * SEQ + s) * LD_PC + 256 + h * 64; dot = 0.f;
#pragma unroll
                for (int c = 0; c < 8; ++c) { float f[8]; unpack8(*(const u32x4*)(kr + c * 8), f);
#pragma unroll
                    for (int ee = 0; ee < 8; ++ee) dot += f[ee] * qs[w][c * 8 + ee]; }
                dot -= sl2 * (float)(t - s); }
            const float cm = wave_max(dot), mn = fmaxf(mx, cm), al = exp2f(mx - mn), pv = valid ? exp2f(dot - mn) : 0.f;
            l = l * al + wave_sum(pv); o *= al; mx = mn;
            const int nk = min(64, total - c0);
            for (int jj = 0; jj < nk; ++jj) { const float pj = rdlane(pv, jj); const int sj = __builtin_amdgcn_readlane(s, jj);
                o += pj * bf2f(PC[((size_t)b * SEQ + sj) * LD_PC + 512 + h * 64 + lane]); }
        }
        const int col = 768 + h * 64 + lane;
        const float g = bf2f(((const bf16_t*)(p.ws + WS_PG))[m * LD_PG + col]);
        ((bf16_t*)(p.ws + WS_Y))[m * DM + col] = (bf16_t)f2bf(o / l * silu(g));
        __builtin_amdgcn_s_waitcnt(0);
    }
}

extern "C" void kernel_launch(void* const* d_in, const int* in_sizes, int n_in, void* d_out, int out_size, void* d_ws, size_t ws_size, hipStream_t stream) {
    static int ok = 0;
    if (ok == 0) {
        if (n_in != 13 || in_sizes[0] != T * DM || out_size != T * DM || ws_size < WS_END) { fprintf(stderr, "kernel_launch: unexpected shapes (n_in %d, in0 %d, out %d, ws %zu)\n", n_in, n_in > 0 ? in_sizes[0] : -1, out_size, ws_size); ok = -1; return; }
        hipFuncSetAttribute((const void*)k_gemm<0>, hipFuncAttributeMaxDynamicSharedMemorySize, GEMM_LDS);
        hipFuncSetAttribute((const void*)k_gemm<1>, hipFuncAttributeMaxDynamicSharedMemorySize, GEMM_LDS);
        hipFuncSetAttribute((const void*)k_gemm<2>, hipFuncAttributeMaxDynamicSharedMemorySize, GEMM_LDS);
        hipFuncSetAttribute((const void*)k_gemm<3>, hipFuncAttributeMaxDynamicSharedMemorySize, GEMM_LDS);
        ok = 1;
    }
    if (ok < 0) return;
    Params p{};
    p.x = (const float*)d_in[0]; p.c = (const float*)d_in[1]; p.w_ada = (const float*)d_in[2]; p.b_ada = (const float*)d_in[3]; p.w_in = (const float*)d_in[4];
    p.qg = (const float*)d_in[5]; p.kvg = (const float*)d_in[6]; p.w_uq = (const float*)d_in[7]; p.w_uk = (const float*)d_in[8]; p.w_uv = (const float*)d_in[9];
    p.w_out = (const float*)d_in[10]; p.ln_g = (const float*)d_in[11]; p.ln_b = (const float*)d_in[12];
    p.out = (float*)d_out; p.ws = (unsigned char*)d_ws; p.layer = 0; p.pad = 0;
    hipLaunchKernelGGL(k_prep, dim3(1024), dim3(256), 0, stream, p);
    hipLaunchKernelGGL(k_mod, dim3(24), dim3(256), 0, stream, p);
    hipLaunchKernelGGL(k_rope, dim3(SEQ * 16 / 256), dim3(256), 0, stream, p);
    for (int l = 0; l < DEPTH; ++l) {
        p.layer = l;
        if (l == 0) hipLaunchKernelGGL(k_makeh, dim3(T * DM / 8 / 256), dim3(256), 0, stream, p, p.x);
        hipLaunchKernelGGL(k_gemm<0>, dim3(256), dim3(512), GEMM_LDS, stream, p);
        hipLaunchKernelGGL(k_rowstat, dim3(T / 4), dim3(256), 0, stream, p);
        hipLaunchKernelGGL(k_gemm<1>, dim3(256), dim3(512), GEMM_LDS, stream, p);
        hipLaunchKernelGGL(k_gemm<2>, dim3(256), dim3(512), GEMM_LDS, stream, p);
        hipLaunchKernelGGL(k_krope, dim3(T * 16 / 256), dim3(256), 0, stream, p);
        hipLaunchKernelGGL(k_idx_naive, dim3(T / 2), dim3(128), 0, stream, p);
        hipLaunchKernelGGL(k_mla_naive, dim3(NB * 6 * SEQ / 4), dim3(256), 0, stream, p);
        hipLaunchKernelGGL(k_dil_naive, dim3(NB * 6 * SEQ / 4), dim3(256), 0, stream, p);
        hipLaunchKernelGGL(k_sparse_naive, dim3(T / 4), dim3(256), 0, stream, p);
        hipLaunchKernelGGL(k_gemm<3>, dim3(256), dim3(512), GEMM_LDS, stream, p);
        hipLaunchKernelGGL(k_ln, dim3(T / 4), dim3(256), 0, stream, p);
    }
}
```

```cpp
#include <hip/hip_runtime.h>
#include <cstdio>
#include <cstdint>
#include <hip/hip_cooperative_groups.h>
namespace cg = cooperative_groups;

#define LAS __attribute__((address_space(3)))
typedef unsigned short bf16_t;
typedef short bf16x8 __attribute__((ext_vector_type(8)));
typedef float f32x4 __attribute__((ext_vector_type(4)));
typedef unsigned u32x4 __attribute__((ext_vector_type(4)));
typedef unsigned long long u64;

constexpr int NB = 8, SEQ = 4096, DM = 1024, T = NB * SEQ, DEPTH = 2;
constexpr int INW = 4584, NIN = 4608;
constexpr int LD_PA = 1024, LD_PB = 1280, LD_PC = 768, LD_PI = 512, LD_PG = 1024;
constexpr int PB_QB = 0, PB_KB = 384, PB_VB = 768, PB_KR = 1152, PB_KI = 1184, PB_WI = 1248;
constexpr int LD_QA = 576, LD_KA = 576, LD_VA = 384;
constexpr float LOG2E = 1.4426950408889634f;
constexpr float QSC64 = 0.125f * LOG2E;
constexpr float QSC96 = 0.10206207261596575f * LOG2E;
constexpr float ALPHA = 1.4142135623730951f;

constexpr size_t MiB = 1u << 20;
constexpr size_t WS_CTL = 0;
constexpr size_t WS_MOD = 1 * MiB;
constexpr size_t WS_ROPE = 1 * MiB + 256 * 1024;
constexpr size_t WS_RST = 1 * MiB + 768 * 1024;
constexpr size_t WS_WIN = 2 * MiB;
constexpr size_t WS_WUQ = 20 * MiB;
constexpr size_t WS_WUKV = 23 * MiB;
constexpr size_t WS_WOUT = 24 * MiB;
constexpr size_t WS_H = 28 * MiB;
constexpr size_t WS_QA = 28 * MiB, WS_VA = 64 * MiB;
constexpr size_t WS_PA = 92 * MiB;
constexpr size_t WS_Y = 92 * MiB;
constexpr size_t WS_PB = 156 * MiB;
constexpr size_t WS_PC = 236 * MiB;
constexpr size_t WS_PI = 284 * MiB;
constexpr size_t WS_PG = 316 * MiB;
constexpr size_t WS_KA = 380 * MiB;
constexpr size_t WS_MASK = 416 * MiB;
constexpr size_t WS_PART = 432 * MiB;
constexpr size_t WS_END = 507 * MiB;

__device__ __forceinline__ float bf2f(unsigned u) { return __uint_as_float(u << 16); }
__device__ __forceinline__ unsigned f2bf(float f) { unsigned u = __float_as_uint(f); return (u + 0x7fffu + ((u >> 16) & 1u)) >> 16; }
__device__ __forceinline__ unsigned pk2(float lo, float hi) { return f2bf(lo) | (f2bf(hi) << 16); }
__device__ __forceinline__ float silu(float x) { return x / (1.0f + __expf(-x)); }
__device__ __forceinline__ float wave_sum(float v) {
#pragma unroll
    for (int o = 1; o < 64; o <<= 1) v += __shfl_xor(v, o);
    return v;
}
__device__ __forceinline__ float wave_max(float v) {
#pragma unroll
    for (int o = 1; o < 64; o <<= 1) v = fmaxf(v, __shfl_xor(v, o));
    return v;
}
__device__ __forceinline__ int wave_sum_i(int v) {
#pragma unroll
    for (int o = 1; o < 64; o <<= 1) v += __shfl_xor(v, o);
    return v;
}
__device__ __forceinline__ void unpack8(const u32x4 v, float* f) {
    f[0] = bf2f(v.x & 0xffffu); f[1] = __uint_as_float(v.x & 0xffff0000u);
    f[2] = bf2f(v.y & 0xffffu); f[3] = __uint_as_float(v.y & 0xffff0000u);
    f[4] = bf2f(v.z & 0xffffu); f[5] = __uint_as_float(v.z & 0xffff0000u);
    f[6] = bf2f(v.w & 0xffffu); f[7] = __uint_as_float(v.w & 0xffff0000u);
}

namespace pg8 {
constexpr int BM = 256, BK = 64, HALF = 128, HTB = HALF * BK * 2, STAGE_BYTES = 8 * HTB, NXCD = 8, WGM = 8;
__host__ __device__ __forceinline__ int lds_byte(int r, int c) { const int st = (r >> 4) * 2 + (c >> 5), rr = r & 15, cc = c & 31, ob = rr * 64 + cc * 2; return st * 1024 + (ob ^ (((ob >> 9) & 1) << 5)); }
__host__ __device__ __forceinline__ void stage_rc(int b, int& R, int& C) { const int st = b / 1024, sb = b % 1024, swz = sb ^ (((sb >> 9) & 1) << 5); R = (st >> 1) * 16 + swz / 64; C = (st & 1) * 32 + (swz % 64) / 2; }
__host__ __device__ __forceinline__ int perm32(int rho) { const int n = rho >> 4, i = rho & 15; return 8 * (i >> 2) + 4 * n + (i & 3); }

struct Unit { int pm, pn; };
struct Gemm { const bf16_t* A; const bf16_t* Bt; int M, N, K, lda, ldb; };

struct StaticOrder {
    int nM, nN, nwg, G, c;
    __host__ __device__ void init(int M, int N, int G_, int c_) { nM = M / BM; nN = N / BM; nwg = nM * nN; G = G_; c = c_; }
    __host__ __device__ bool next(int i, Unit& u) const {
        const long L = (long)i * G + c; if (L >= nwg) return false;
        int wgid = (int)L; { const int q = nwg / NXCD, r = nwg % NXCD, xcd = wgid % NXCD, off = wgid / NXCD; wgid = (xcd < r ? xcd * (q + 1) : r * (q + 1) + (xcd - r) * q) + off; }
        const int nig = WGM * nN, gid = wgid / nig, fm = gid * WGM, gsz = (nM - fm) < WGM ? (nM - fm) : WGM;
        u.pm = fm + ((wgid % nig) % gsz); u.pn = (wgid % nig) / gsz; return true;
    }
};

template <class F> struct EpiChunk {
    static constexpr bool PERM = true;
    F f;
    __device__ __forceinline__ void operator()(const f32x4 (&acc)[2][2][4][2], const Unit& u, int wr, int wc, int fr, int fq) const {
        const int row0 = u.pm * BM + wr * 64 + fr, col0 = u.pn * BM + wc * 32 + 8 * fq;
#pragma unroll
        for (int ai = 0; ai < 2; ++ai)
#pragma unroll
            for (int m = 0; m < 4; ++m)
#pragma unroll
                for (int bj = 0; bj < 2; ++bj) f(row0 + ai * HALF + m * 16, col0 + bj * HALF, acc[ai][bj][m][0], acc[ai][bj][m][1]);
    }
};

template <class Epi, class Sched, bool ALIGN_EPI>
__device__ __forceinline__ void gemm_phase(LAS unsigned char* lds, const Gemm g, const Sched& S, const Epi& E) {
    int tid = threadIdx.x; asm volatile("" : "+v"(tid));
    const int wid = __builtin_amdgcn_readfirstlane(tid >> 6), lane = tid & 63, wr = wid >> 2, wc = wid & 3, fr = lane & 15, fq = lane >> 4;
    const int K = g.K, nt = K / BK;
    unsigned voffA[2], voffB[2];
#pragma unroll
    for (int i = 0; i < 2; ++i) { int R, C; stage_rc(tid * 16 + i * 8192, R, C); const int Rb = Epi::PERM ? ((R & ~31) + perm32(R & 31)) : R;
        voffA[i] = (unsigned)(R * g.lda + C) * 2u; voffB[i] = (unsigned)(Rb * g.ldb + C) * 2u; }
    const size_t kstep = (size_t)(BK * 2);
    const size_t hsA = (size_t)HALF * g.lda * 2, hsB = (size_t)HALF * g.ldb * 2;
    const size_t tsA = 2 * hsA, tsB = 2 * hsB;
    const unsigned ldsw = (unsigned)wid * 1024u;
    const int aoff = lds_byte(wr * 64 + fr, fq * 8), boff = lds_byte(wc * 32 + fr, fq * 8);
#define PG8_SA(b, h) (((b) * 2 + (h)) * HTB)
#define PG8_SB(b, h) ((4 + (b) * 2 + (h)) * HTB)
#define PG8_STAGE(bufoff, gbase, voff) do { _Pragma("unroll") for (int _i = 0; _i < 2; ++_i) \
        __builtin_amdgcn_global_load_lds((const unsigned*)((const char*)(gbase) + (voff)[_i]), (LAS unsigned*)(lds + (bufoff) + ldsw + _i * 8192), 16, 0, 0); } while (0)
#define PG8_LDA(dst, b, h) do { _Pragma("unroll") for (int m = 0; m < 4; ++m) _Pragma("unroll") for (int k = 0; k < 2; ++k) dst[m][k] = *(const LAS bf16x8*)(lds + PG8_SA(b, h) + aoff + m * 2048 + k * 1024); } while (0)
#define PG8_LDB(dst, b, h) do { _Pragma("unroll") for (int n = 0; n < 2; ++n) _Pragma("unroll") for (int k = 0; k < 2; ++k) dst[n][k] = *(const LAS bf16x8*)(lds + PG8_SB(b, h) + boff + n * 2048 + k * 1024); } while (0)
#define PG8_MMA(ai, bj, At, Bt) do { __builtin_amdgcn_s_setprio(1); _Pragma("unroll") for (int m = 0; m < 4; ++m) _Pragma("unroll") for (int n = 0; n < 2; ++n) _Pragma("unroll") for (int k = 0; k < 2; ++k) \
        acc[ai][bj][m][n] = __builtin_amdgcn_mfma_f32_16x16x32_bf16(Bt[n][k], At[m][k], acc[ai][bj][m][n], 0, 0, 0); __builtin_amdgcn_s_setprio(0); } while (0)
#define PG8_WAIT_V(n) asm volatile("s_waitcnt vmcnt(" #n ")" ::: "memory")
#define PG8_WAIT_L(n) asm volatile("s_waitcnt lgkmcnt(" #n ")" ::: "memory")
#define PG8_BAR __builtin_amdgcn_s_barrier()
#define PG8_SCHED __builtin_amdgcn_sched_barrier(0)
    Unit cur, nxt; int ui = 0;
    if (!S.next(0, cur)) return;
    f32x4 acc[2][2][4][2];
#pragma unroll
    for (int a = 0; a < 2; ++a)
#pragma unroll
        for (int b = 0; b < 2; ++b)
#pragma unroll
            for (int m = 0; m < 4; ++m)
#pragma unroll
                for (int n = 0; n < 2; ++n) acc[a][b][m][n] = (f32x4){0.f, 0.f, 0.f, 0.f};
    bf16x8 At[4][2], B0[2][2], B1[2][2];
    const char* cA = (const char*)g.A + (size_t)cur.pm * tsA; const char* cB = (const char*)g.Bt + (size_t)cur.pn * tsB;
    PG8_STAGE(PG8_SB(0, 0), cB, voffB); PG8_STAGE(PG8_SB(0, 1), cB + hsB, voffB); PG8_STAGE(PG8_SA(0, 0), cA, voffA); PG8_STAGE(PG8_SA(0, 1), cA + hsA, voffA);
    if (wr == 1) PG8_BAR;
    PG8_WAIT_V(2); PG8_BAR;
    PG8_STAGE(PG8_SB(1, 0), cB + kstep, voffB); PG8_STAGE(PG8_SA(1, 0), cA + kstep, voffA); PG8_STAGE(PG8_SB(1, 1), cB + hsB + kstep, voffB);
    PG8_WAIT_V(6); PG8_BAR;
    for (;;) {
        const bool has_next = S.next(ui + 1, nxt);
        const char* nA = has_next ? (const char*)g.A + (size_t)nxt.pm * tsA : cA; const char* nB = has_next ? (const char*)g.Bt + (size_t)nxt.pn * tsB : cB;
#pragma nounroll
        for (int t = 0; t < nt; t += 2) {
            const bool last = (t == nt - 2);
            const char* a1 = cA + (size_t)(t + 1) * kstep;
            const char* a2 = last ? nA : cA + (size_t)(t + 2) * kstep; const char* b2 = last ? nB : cB + (size_t)(t + 2) * kstep;
            const char* a3 = a2 + kstep; const char* b3 = b2 + kstep;
            PG8_LDB(B0, 0, 0); PG8_LDB(B1, 0, 1); PG8_SCHED; PG8_LDA(At, 0, 0); PG8_STAGE(PG8_SA(1, 1), a1 + hsA, voffA);
            PG8_WAIT_V(8); PG8_WAIT_L(0); PG8_BAR; PG8_MMA(0, 0, At, B0); PG8_MMA(0, 1, At, B1); PG8_BAR; PG8_SCHED;
            PG8_LDA(At, 0, 1); PG8_STAGE(PG8_SB(0, 0), b2, voffB); PG8_STAGE(PG8_SB(0, 1), b2 + hsB, voffB); PG8_STAGE(PG8_SA(0, 0), a2, voffA);
            PG8_WAIT_V(8); PG8_WAIT_L(0); PG8_BAR; PG8_MMA(1, 0, At, B0); PG8_MMA(1, 1, At, B1); PG8_BAR; PG8_SCHED;
            PG8_LDB(B0, 1, 0); PG8_LDB(B1, 1, 1); PG8_SCHED; PG8_LDA(At, 1, 0); PG8_STAGE(PG8_SA(0, 1), a2 + hsA, voffA);
            PG8_WAIT_V(8); PG8_WAIT_L(0); PG8_BAR; PG8_MMA(0, 0, At, B0); PG8_MMA(0, 1, At, B1); PG8_BAR; PG8_SCHED;
            PG8_LDA(At, 1, 1); PG8_STAGE(PG8_SB(1, 0), b3, voffB); PG8_STAGE(PG8_SB(1, 1), b3 + hsB, voffB); PG8_STAGE(PG8_SA(1, 0), a3, voffA);
            PG8_WAIT_V(8); PG8_WAIT_L(0); PG8_BAR; PG8_MMA(1, 0, At, B0); PG8_MMA(1, 1, At, B1); PG8_BAR; PG8_SCHED;
        }
        if constexpr (ALIGN_EPI) { if (wr == 0) PG8_BAR; }
        E(acc, cur, wr, wc, fr, fq);
        if (!has_next) break;
#pragma unroll
        for (int a = 0; a < 2; ++a)
#pragma unroll
            for (int b = 0; b < 2; ++b)
#pragma unroll
                for (int m = 0; m < 4; ++m)
#pragma unroll
                    for (int n = 0; n < 2; ++n) acc[a][b][m][n] = (f32x4){0.f, 0.f, 0.f, 0.f};
        cur = nxt; cA = nA; cB = nB; ++ui;
        if constexpr (ALIGN_EPI) { if (wr == 1) PG8_BAR; }
    }
    PG8_WAIT_V(0);
    if constexpr (!ALIGN_EPI) { if (wr == 0) PG8_BAR; }
    PG8_BAR;
#undef PG8_SA
#undef PG8_SB
#undef PG8_STAGE
#undef PG8_LDA
#undef PG8_LDB
#undef PG8_MMA
#undef PG8_WAIT_V
#undef PG8_WAIT_L
#undef PG8_BAR
#undef PG8_SCHED
}
}

struct Params {
    const float* x; const float* c; const float* w_ada; const float* b_ada; const float* w_in; const float* qg; const float* kvg;
    const float* w_uq; const float* w_uk; const float* w_uv; const float* w_out; const float* ln_g; const float* ln_b;
    float* out; unsigned char* ws; int layer; int pad;
};

constexpr int NWAVES = 8, NTHREADS = 512;
constexpr int LDS_BYTES = 152 * 1024;
struct Ctx { LAS unsigned char* lds; int tid, lane, wave, gw, ngw; };
__device__ __forceinline__ Ctx fresh_ctx(LAS unsigned char* lds) {
    Ctx C; C.lds = lds; int t = threadIdx.x; asm volatile("" : "+v"(t)); C.tid = t; C.lane = t & 63; C.wave = __builtin_amdgcn_readfirstlane(t >> 6);
    C.gw = blockIdx.x * NWAVES + C.wave; C.ngw = gridDim.x * NWAVES; return C; }

__device__ __forceinline__ int map_in(int n, float& sc) {
    sc = 1.f;
    if (n < 1024) return n;
    if (n < 2304) { const int j = n - 1024;
        if (j < 384) { sc = QSC64; return 1056 + j; }
        if (j < 768) return 1440 + (j - 384);
        if (j < 1152) return 1824 + (j - 768);
        if (j < 1184) { const int w = j - 1152; return 1024 + (w >> 1) + 16 * (w & 1); }
        if (j < 1248) return 3488 + (j - 1184);
        if (j < 1256) return 3552 + (j - 1248);
        return -1; }
    if (n < 3072) { const int j = n - 2304; if (j < 256) sc = QSC64; return 2208 + j; }
    if (n < 3584) return 2976 + (n - 3072);
    return 3560 + (n - 3584);
}
constexpr int PT_IN = 72 * 16, PT_UQ = 12 * 12, PT_UKV = 12 * 4, PT_OUT = 16 * 16, PT_L = PT_IN + PT_UQ + PT_UKV + PT_OUT, PREP_TILES = 2 * PT_L;
__device__ __forceinline__ void prep_tile(const Params& p, int tile, LAS float* tl  ) {
    const int tid = threadIdx.x;
    const int l = tile / PT_L; int r = tile % PT_L;
    int kind, K;
    if (r < PT_IN) { kind = 0; K = 1024; } else if ((r -= PT_IN) < PT_UQ) { kind = 1; K = 768; } else if ((r -= PT_UQ) < PT_UKV) { kind = 2; K = 256; } else { r -= PT_UKV; kind = 3; K = 1024; }
    const int nkb = K / 64, n0 = (r / nkb) * 64, k0 = (r % nkb) * 64;
    const int i = tid & 63, j = tid >> 6, n = n0 + i;
    const float* src = nullptr; int srcN = 0, scol = -1; float cs = 1.f; const float* ks = nullptr; bf16_t* dst = nullptr;
    if (kind == 0) { src = p.w_in + (size_t)l * 1024 * INW; srcN = INW; scol = map_in(n, cs); dst = (bf16_t*)(p.ws + WS_WIN) + (size_t)l * NIN * 1024; }
    else if (kind == 1) { src = p.w_uq + (size_t)l * 768 * 576; srcN = 576; ks = p.qg + l * 768; cs = QSC96; dst = (bf16_t*)(p.ws + WS_WUQ) + (size_t)l * 768 * 768;
        if (n < 576) { const int h = n / 96, w = n % 96; scol = (w < 64) ? 96 * h + w : 96 * h + 64 + ((w - 64) >> 1) + 16 * ((w - 64) & 1); } }
    else if (kind == 2) { ks = p.kvg + l * 256; dst = (bf16_t*)(p.ws + WS_WUKV) + (size_t)l * 768 * 256; srcN = 384;
        if (n < 384) { src = p.w_uk + (size_t)l * 256 * 384; scol = n; } else { src = p.w_uv + (size_t)l * 256 * 384; scol = n - 384; } }
    else { src = p.w_out + (size_t)l * 1024 * 1024; srcN = 1024; scol = n; dst = (bf16_t*)(p.ws + WS_WOUT) + (size_t)l * 1024 * 1024; }
#pragma unroll
    for (int kk = j; kk < 64; kk += 8) { const int k = k0 + kk; float v = 0.f; if (scol >= 0) { v = src[(size_t)k * srcN + scol] * cs; if (ks) v *= ks[k]; } tl[kk * 65 + i] = v; }
    __syncthreads();
    { const int nn = tid >> 3, kc = tid & 7; u32x4 o;
      o.x = pk2(tl[(kc * 8 + 0) * 65 + nn], tl[(kc * 8 + 1) * 65 + nn]); o.y = pk2(tl[(kc * 8 + 2) * 65 + nn], tl[(kc * 8 + 3) * 65 + nn]);
      o.z = pk2(tl[(kc * 8 + 4) * 65 + nn], tl[(kc * 8 + 5) * 65 + nn]); o.w = pk2(tl[(kc * 8 + 6) * 65 + nn], tl[(kc * 8 + 7) * 65 + nn]);
      *(u32x4*)(dst + (size_t)(n0 + nn) * K + k0 + kc * 8) = o; }
    __syncthreads();
}
constexpr int MOD_ITEMS = 2 * 48;
__device__ __forceinline__ void mod_item(const Params& p, int item, LAS float* sc  , LAS float* part  ) {
    const int tid = threadIdx.x, l = item / 48, j0 = (item % 48) * 64, col = tid & 63, kg = tid >> 6;
    float acc[NB];
#pragma unroll
    for (int b = 0; b < NB; ++b) acc[b] = 0.f;
    const float* w = p.w_ada + (size_t)l * 1024 * 3072 + j0 + col;
    for (int k = kg * 128; k < kg * 128 + 128; ++k) { const float wv = w[(size_t)k * 3072];
#pragma unroll
        for (int b = 0; b < NB; ++b) acc[b] += sc[b * 1024 + k] * wv; }
#pragma unroll
    for (int b = 0; b < NB; ++b) part[(kg * 8 + b) * 64 + col] = acc[b];
    __syncthreads();
    { const int b = tid >> 6; float s = p.b_ada[l * 3072 + j0 + col];
#pragma unroll
      for (int g = 0; g < 8; ++g) s += part[(g * 8 + b) * 64 + col];
      ((float*)(p.ws + WS_MOD))[((size_t)l * NB + b) * 3072 + j0 + col] = s; }
    __syncthreads();
}
__device__ __forceinline__ void rope_entry(int pos, int i, float& c, float& s) {
    const float th = exp2f(-(float)i * (13.287712379549449f / 16.0f));
    const float angf = (float)pos * th;
    const double a = (double)angf, n = rint(a * 0.15915494309189535), r = (a - n * 6.283185307179586) - n * 2.4492935982947064e-16;
    const double r2 = r * r; double sn = 0.0, cs = 0.0, ts = r, tc = 1.0;
#pragma unroll
    for (int k = 0; k < 14; ++k) { sn += ts; cs += tc; tc = -tc * r2 / (double)((2 * k + 1) * (2 * k + 2)); ts = -ts * r2 / (double)((2 * k + 2) * (2 * k + 3)); }
    c = (float)cs; s = (float)sn;
}
__device__ __forceinline__ void phase_prologue(const Params& p, const Ctx& C) {
    LAS float* tl = (LAS float*)C.lds;
    for (int t = blockIdx.x; t < PREP_TILES; t += gridDim.x) prep_tile(p, t, tl);
    if ((int)blockIdx.x < MOD_ITEMS) {
        LAS float* sc = (LAS float*)C.lds; LAS float* part = sc + NB * 1024;
        for (int e = C.tid; e < NB * 1024; e += NTHREADS) sc[e] = silu(p.c[e]);
        __syncthreads();
        mod_item(p, blockIdx.x, sc, part);
    }
    float* tab = (float*)(p.ws + WS_ROPE);
    for (int e = blockIdx.x * NTHREADS + C.tid; e < SEQ * 16; e += gridDim.x * NTHREADS) { float c, s; rope_entry(e >> 4, e & 15, c, s); tab[2 * e] = c; tab[2 * e + 1] = s; }
}
__device__ __forceinline__ void phase_makeh(const Params& p, const Ctx& C) {
    for (size_t e = ((size_t)blockIdx.x * NTHREADS + C.tid) * 8; e < (size_t)T * DM; e += (size_t)gridDim.x * NTHREADS * 8) {
        const int m = (int)(e >> 10), k = (int)(e & 1023), b = m / SEQ;
        const float* mod = (const float*)(p.ws + WS_MOD) + (size_t)b * 3072;
        const f32x4 x0 = *(const f32x4*)(p.x + e), x1 = *(const f32x4*)(p.x + e + 4);
        const f32x4 sh0 = *(const f32x4*)(mod + k), sh1 = *(const f32x4*)(mod + k + 4), s0 = *(const f32x4*)(mod + 1024 + k), s1 = *(const f32x4*)(mod + 1024 + k + 4);
        const f32x4 h0 = x0 * (s0 + 1.0f) + sh0, h1 = x1 * (s1 + 1.0f) + sh1;
        u32x4 o; o.x = pk2(h0.x, h0.y); o.y = pk2(h0.z, h0.w); o.z = pk2(h1.x, h1.y); o.w = pk2(h1.z, h1.w);
        *(u32x4*)((bf16_t*)(p.ws + WS_H) + e) = o;
    }
}
__device__ __forceinline__ void phase_rowstat(const Params& p, const Ctx& C) {
    const int lane = C.lane;
    for (int m = C.gw; m < T; m += C.ngw) {
        const bf16_t* row = (const bf16_t*)(p.ws + WS_PA) + (size_t)m * LD_PA;
        float f[8]; float sq = 0.f, skv = 0.f;
        unpack8(*(const u32x4*)(row + lane * 8), f);
#pragma unroll
        for (int e = 0; e < 8; ++e) sq += f[e] * f[e];
        unpack8(*(const u32x4*)(row + 512 + lane * 8), f);
        float s2 = 0.f;
#pragma unroll
        for (int e = 0; e < 8; ++e) s2 += f[e] * f[e];
        if (lane < 32) sq += s2; else skv += s2;
        sq = wave_sum(sq); skv = wave_sum(skv);
        if (lane == 0) { float* rs = (float*)(p.ws + WS_RST) + 2 * m; rs[0] = rsqrtf(sq * (1.0f / 768.0f) + 1e-6f); rs[1] = rsqrtf(skv * (1.0f / 256.0f) + 1e-6f); }
    }
}
__device__ __forceinline__ void phase_krope(const Params& p, const Ctx& C) {
    for (int e = blockIdx.x * NTHREADS + C.tid; e < T * 16; e += gridDim.x * NTHREADS) {
        const int m = e >> 4, i = e & 15, pos = m % SEQ;
        const bf16_t* pb = (const bf16_t*)(p.ws + WS_PB) + (size_t)m * LD_PB + PB_KR;
        const unsigned pr = *(const unsigned*)(pb + 2 * i);
        const float x1 = bf2f(pr & 0xffffu), x2 = __uint_as_float(pr & 0xffff0000u);
        const float* tab = (const float*)(p.ws + WS_ROPE) + ((size_t)pos * 16 + i) * 2; const float c = tab[0], s = tab[1];
        const unsigned o = pk2(x1 * c - x2 * s, x1 * s + x2 * c);
        bf16_t* ka = (bf16_t*)(p.ws + WS_KA) + (size_t)m * LD_KA;
#pragma unroll
        for (int h = 0; h < 6; ++h) *(unsigned*)(ka + h * 96 + 64 + 2 * i) = o;
    }
}

__device__ __forceinline__ u32x4 pack8(f32x4 v0, f32x4 v1) { u32x4 w; w.x = pk2(v0[0], v0[1]); w.y = pk2(v0[2], v0[3]); w.z = pk2(v1[0], v1[1]); w.w = pk2(v1[2], v1[3]); return w; }
struct FIn { unsigned char* ws;
    __device__ __forceinline__ void operator()(int row, int col, f32x4 v0, f32x4 v1) const {
        const int pn = col >> 8; unsigned base, ld, c0;
        if (pn < 4) { base = (unsigned)WS_PA; ld = LD_PA; c0 = col; }
        else if (pn < 9) { base = (unsigned)WS_PB; ld = LD_PB; c0 = col - 1024; }
        else if (pn < 12) { base = (unsigned)WS_PC; ld = LD_PC; c0 = col - 2304; }
        else if (pn < 14) { base = (unsigned)WS_PI; ld = LD_PI; c0 = col - 3072; }
        else { base = (unsigned)WS_PG; ld = LD_PG; c0 = col - 3584; }
        *(u32x4*)(ws + (base + ((unsigned)row * ld + c0) * 2u)) = pack8(v0, v1);
    }
};
struct FUq { unsigned char* ws;
    __device__ __forceinline__ void operator()(int row, int col, f32x4 v0, f32x4 v1) const {
        if (col >= 576) return;
        const float r = *(const float*)(ws + ((unsigned)WS_RST + (unsigned)row * 8u));
        v0 = v0 * r; v1 = v1 * r;
        const int w = col % 96;
        if (w >= 64) { const unsigned i0 = (unsigned)(w - 64) >> 1, pos = (unsigned)row % SEQ; const unsigned to = (unsigned)WS_ROPE + (pos * 16u + i0) * 8u;
            const f32x4 t0 = *(const f32x4*)(ws + to), t1 = *(const f32x4*)(ws + to + 16u);
            f32x4 a, b;
            a[0] = v0[0] * t0[0] - v0[1] * t0[1]; a[1] = v0[0] * t0[1] + v0[1] * t0[0];
            a[2] = v0[2] * t0[2] - v0[3] * t0[3]; a[3] = v0[2] * t0[3] + v0[3] * t0[2];
            b[0] = v1[0] * t1[0] - v1[1] * t1[1]; b[1] = v1[0] * t1[1] + v1[1] * t1[0];
            b[2] = v1[2] * t1[2] - v1[3] * t1[3]; b[3] = v1[2] * t1[3] + v1[3] * t1[2];
            v0 = a; v1 = b; }
        *(u32x4*)(ws + ((unsigned)WS_QA + ((unsigned)row * LD_QA + (unsigned)col) * 2u)) = pack8(v0, v1);
    }
};
struct FUkv { unsigned char* ws;
    __device__ __forceinline__ void operator()(int row, int col, f32x4 v0, f32x4 v1) const {
        const float r = *(const float*)(ws + ((unsigned)WS_RST + (unsigned)row * 8u + 4u));
        v0 = v0 * r; v1 = v1 * r;
        const unsigned off = (col < 384) ? (unsigned)WS_KA + ((unsigned)row * LD_KA + (unsigned)((col >> 6) * 96 + (col & 63))) * 2u
                                         : (unsigned)WS_VA + ((unsigned)row * LD_VA + (unsigned)(col - 384)) * 2u;
        *(u32x4*)(ws + off) = pack8(v0, v1);
    }
};
struct FOut { const float* xin; float* out; const float* mod;
    __device__ __forceinline__ void operator()(int row, int col, f32x4 v0, f32x4 v1) const {
        const unsigned b = (unsigned)row / SEQ; const unsigned go = (b * 3072u + 2048u + (unsigned)col) * 4u;
        const f32x4 g0 = *(const f32x4*)((const char*)mod + go), g1 = *(const f32x4*)((const char*)mod + go + 16u);
        const unsigned off = ((unsigned)row * DM + (unsigned)col) * 4u;
        const f32x4 x0 = *(const f32x4*)((const char*)xin + off), x1 = *(const f32x4*)((const char*)xin + off + 16u);
        *(f32x4*)((char*)out + off) = x0 * ALPHA + (g0 + 1.0f) * v0; *(f32x4*)((char*)out + off + 16u) = x1 * ALPHA + (g1 + 1.0f) * v1;
    }
};
template <int WHICH> __device__ __forceinline__ void phase_gemm(const Params& p, const Ctx& C, int l) {
    pg8::StaticOrder S;
    if constexpr (WHICH == 0) {
        pg8::Gemm g{(const bf16_t*)(p.ws + WS_H), (const bf16_t*)(p.ws + WS_WIN) + (size_t)l * NIN * 1024, T, NIN, 1024, 1024, 1024};
        S.init(T, NIN, gridDim.x, blockIdx.x); pg8::EpiChunk<FIn> E{FIn{p.ws}};
        pg8::gemm_phase<pg8::EpiChunk<FIn>, pg8::StaticOrder, true>(C.lds, g, S, E);
    } else if constexpr (WHICH == 1) {
        pg8::Gemm g{(const bf16_t*)(p.ws + WS_PA), (const bf16_t*)(p.ws + WS_WUQ) + (size_t)l * 768 * 768, T, 768, 768, LD_PA, 768};
        S.init(T, 768, gridDim.x, blockIdx.x); pg8::EpiChunk<FUq> E{FUq{p.ws}};
        pg8::gemm_phase<pg8::EpiChunk<FUq>, pg8::StaticOrder, true>(C.lds, g, S, E);
    } else if constexpr (WHICH == 2) {
        pg8::Gemm g{(const bf16_t*)(p.ws + WS_PA) + 768, (const bf16_t*)(p.ws + WS_WUKV) + (size_t)l * 768 * 256, T, 768, 256, LD_PA, 256};
        S.init(T, 768, gridDim.x, blockIdx.x); pg8::EpiChunk<FUkv> E{FUkv{p.ws}};
        pg8::gemm_phase<pg8::EpiChunk<FUkv>, pg8::StaticOrder, true>(C.lds, g, S, E);
    } else {
        pg8::Gemm g{(const bf16_t*)(p.ws + WS_Y), (const bf16_t*)(p.ws + WS_WOUT) + (size_t)l * 1024 * 1024, T, 1024, 1024, 1024, 1024};
        S.init(T, 1024, gridDim.x, blockIdx.x);
        pg8::EpiChunk<FOut> E{FOut{l == 0 ? p.x : p.out, p.out, (const float*)(p.ws + WS_MOD) + (size_t)l * NB * 3072}};
        pg8::gemm_phase<pg8::EpiChunk<FOut>, pg8::StaticOrder, true>(C.lds, g, S, E);
    }
}
__device__ __forceinline__ void phase_ln(const Params& p, const Ctx& C, int l) {
    const int lane = C.lane;
    for (int m = C.gw; m < T; m += C.ngw) {
        float* row = p.out + (size_t)m * DM;
        f32x4 v[4]; float s = 0.f;
#pragma unroll
        for (int j = 0; j < 4; ++j) { v[j] = *(const f32x4*)(row + j * 256 + lane * 4); s += (v[j].x + v[j].y) + (v[j].z + v[j].w); }
        const float mean = wave_sum(s) * (1.0f / DM); float s2 = 0.f;
#pragma unroll
        for (int j = 0; j < 4; ++j) { v[j] = v[j] - mean; s2 += (v[j].x * v[j].x + v[j].y * v[j].y) + (v[j].z * v[j].z + v[j].w * v[j].w); }
        const float rstd = rsqrtf(wave_sum(s2) * (1.0f / DM) + 1e-5f);
        const float* g = p.ln_g + l * DM; const float* bb = p.ln_b + l * DM;
        const int b = m / SEQ; const float* mod = (const float*)(p.ws + WS_MOD) + ((size_t)(l + 1) * NB + b) * 3072;
#pragma unroll
        for (int j = 0; j < 4; ++j) { const int k = j * 256 + lane * 4;
            const f32x4 y = v[j] * rstd * *(const f32x4*)(g + k) + *(const f32x4*)(bb + k);
            *(f32x4*)(row + k) = y;
            if (l + 1 < DEPTH) { const f32x4 h = y * (*(const f32x4*)(mod + 1024 + k) + 1.0f) + *(const f32x4*)(mod + k);
                unsigned long long o = (unsigned long long)pk2(h.x, h.y) | ((unsigned long long)pk2(h.z, h.w) << 32);
                *(unsigned long long*)((bf16_t*)(p.ws + WS_H) + (size_t)m * DM + k) = o; } }
    }
}

constexpr int WSCR = 18944;
__device__ __forceinline__ float rdlane(float v, int l) { return __uint_as_float(__builtin_amdgcn_readlane(__float_as_uint(v), l)); }
__device__ __forceinline__ float alibi_slope(int i) { return exp2f(-0.8f * (float)i); }
#define WAVE_LDS_FENCE() asm volatile("s_waitcnt lgkmcnt(0)" ::: "memory")

__device__ __forceinline__ void phase_mla_naive(const Params& p, const Ctx& C) {
    LAS float* qs = (LAS float*)(C.lds + C.wave * WSCR);
    const int lane = C.lane;
    const bf16_t* QA = (const bf16_t*)(p.ws + WS_QA); const bf16_t* KA = (const bf16_t*)(p.ws + WS_KA); const bf16_t* VA = (const bf16_t*)(p.ws + WS_VA);
    for (int qi = C.gw; qi < NB * 6 * SEQ; qi += C.ngw) {
        const int t = qi % SEQ, h = (qi / SEQ) % 6, b = qi / (SEQ * 6);
        const size_t m = (size_t)b * SEQ + t;
        WAVE_LDS_FENCE();
        for (int e = lane; e < 96; e += 64) qs[e] = bf2f(QA[m * LD_QA + h * 96 + e]);
        WAVE_LDS_FENCE();
        float mx = -INFINITY, l = 0.f, o = 0.f;
        for (int c0 = 0; c0 <= t; c0 += 64) {
            const int s = c0 + lane; const bool valid = s <= t; float dot = -INFINITY;
            if (valid) { const bf16_t* kr = KA + ((size_t)b * SEQ + s) * LD_KA + h * 96; dot = 0.f;
#pragma unroll
                for (int c = 0; c < 12; ++c) { float f[8]; unpack8(*(const u32x4*)(kr + c * 8), f);
#pragma unroll
                    for (int e = 0; e < 8; ++e) dot += f[e] * qs[c * 8 + e]; } }
            const float cm = wave_max(dot), mn = fmaxf(mx, cm), al = exp2f(mx - mn), pv = valid ? exp2f(dot - mn) : 0.f;
            l = l * al + wave_sum(pv); o *= al; mx = mn;
            const int nk = min(64, t - c0 + 1);
            for (int j = 0; j < nk; ++j) { const float pj = rdlane(pv, j); o += pj * bf2f(VA[((size_t)b * SEQ + c0 + j) * LD_VA + h * 64 + lane]); }
        }
        const int col = h * 64 + lane;
        const float g = bf2f(((const bf16_t*)(p.ws + WS_PG))[m * LD_PG + col]);
        ((bf16_t*)(p.ws + WS_Y))[m * DM + col] = (bf16_t)f2bf(o / l * silu(g));
    }
}
__device__ __forceinline__ void phase_dil_naive(const Params& p, const Ctx& C) {
    LAS float* qs = (LAS float*)(C.lds + C.wave * WSCR);
    const int lane = C.lane;
    const bf16_t* PB = (const bf16_t*)(p.ws + WS_PB);
    for (int qi = C.gw; qi < NB * 6 * SEQ; qi += C.ngw) {
        const int t = qi % SEQ, h = (qi / SEQ) % 6, b = qi / (SEQ * 6);
        const size_t m = (size_t)b * SEQ + t;
        WAVE_LDS_FENCE();
        qs[lane] = bf2f(PB[m * LD_PB + PB_QB + h * 64 + lane]);
        WAVE_LDS_FENCE();
        const float sl2 = alibi_slope(h + 1) * LOG2E;
        float mx = -INFINITY, l = 0.f, o = 0.f;
        for (int c0 = 0; c0 < 387; c0 += 64) {
            const int e = c0 + lane; const int pat = e / 129, j = e % 129, d = (pat == 0) ? 1 : (pat == 1) ? 4 : 16; const int s = t - j * d;
            const bool valid = (e < 387) && (s >= 0); float dot = -INFINITY;
            if (valid) { const bf16_t* kr = PB + ((size_t)b * SEQ + s) * LD_PB + PB_KB + h * 64; dot = 0.f;
#pragma unroll
                for (int c = 0; c < 8; ++c) { float f[8]; unpack8(*(const u32x4*)(kr + c * 8), f);
#pragma unroll
                    for (int ee = 0; ee < 8; ++ee) dot += f[ee] * qs[c * 8 + ee]; }
                dot -= sl2 * (float)(j * d); }
            const float cm = wave_max(dot), mn = fmaxf(mx, cm), al = exp2f(mx - mn), pv = valid ? exp2f(dot - mn) : 0.f;
            l = l * al + wave_sum(pv); o *= al; mx = mn;
            for (int jj = 0; jj < 64; ++jj) { const float pj = rdlane(pv, jj); const int sj = __builtin_amdgcn_readlane(s, jj);
                if (pj != 0.f) o += pj * bf2f(PB[((size_t)b * SEQ + sj) * LD_PB + PB_VB + h * 64 + lane]); }
        }
        const int col = 384 + h * 64 + lane;
        const float g = bf2f(((const bf16_t*)(p.ws + WS_PG))[m * LD_PG + col]);
        ((bf16_t*)(p.ws + WS_Y))[m * DM + col] = (bf16_t)f2bf(o / l * silu(g));
    }
}
__device__ __forceinline__ unsigned fkey(float f) { unsigned u = __float_as_uint(f); if (u == 0x80000000u) u = 0u; return (u & 0x80000000u) ? ~u : (u | 0x80000000u); }
__device__ __forceinline__ u64 select_row(const LAS float* sc, int lane) {
    unsigned u[64];
#pragma unroll
    for (int r = 0; r < 64; ++r) u[r] = fkey(sc[r * 64 + lane]);
    unsigned thr = 0u;
    for (int bit = 31; bit >= 0; --bit) {
        const unsigned cand = thr | (1u << bit); int c = 0;
#pragma unroll
        for (int r = 0; r < 64; ++r) c += (u[r] >= cand) ? 1 : 0;
        c = wave_sum_i(c);
        if (c >= 256) { thr = cand; if (c == 256) break; }
    }
    int cgt = 0;
#pragma unroll
    for (int r = 0; r < 64; ++r) cgt += (u[r] > thr) ? 1 : 0;
    cgt = wave_sum_i(cgt);
    int need = 256 - cgt, run = 0; u64 mine = 0ull;
    const u64 ltmask = (lane == 0) ? 0ull : (~0ull >> (64 - lane));
#pragma unroll
    for (int r = 0; r < 64; ++r) {
        const bool gt = u[r] > thr, eq = u[r] == thr;
        const u64 beq = __ballot(eq);
        const int pos = run + __popcll(beq & ltmask);
        const u64 word = __ballot(gt || (eq && pos < need));
        run += __popcll(beq);
        if (lane == r) mine = word;
    }
    return mine;
}
__device__ __forceinline__ void phase_idx_naive(const Params& p, const Ctx& C) {
    LAS float* sc = (LAS float*)(C.lds + C.wave * WSCR); LAS float* qs = sc + 4096; LAS float* wsm = qs + 512;
    const int lane = C.lane;
    const bf16_t* PI = (const bf16_t*)(p.ws + WS_PI); const bf16_t* PB = (const bf16_t*)(p.ws + WS_PB);
    for (int qi = C.gw; qi < T; qi += C.ngw) {
        const int t = qi % SEQ, b = qi / SEQ;
        const size_t m = (size_t)b * SEQ + t;
        u64* mrow = (u64*)(p.ws + WS_MASK) + m * 64;
        if (t < 256) {
            const int lo = lane * 64; u64 word = 0ull;
            if (t >= lo + 63) word = ~0ull; else if (t >= lo) word = (~0ull) >> (63 - (t - lo));
            mrow[lane] = word; continue;
        }
        WAVE_LDS_FENCE();
        for (int e = lane; e < 512; e += 64) qs[e] = bf2f(PI[m * LD_PI + e]);
        if (lane < 8) wsm[lane] = bf2f(PB[m * LD_PB + PB_WI + lane]);
        WAVE_LDS_FENCE();
        for (int c0 = 0; c0 < 4096; c0 += 64) {
            const int s = c0 + lane; float score = -INFINITY;
            if (c0 <= t) {
                if (s <= t) { const bf16_t* kr = PB + ((size_t)b * SEQ + s) * LD_PB + PB_KI; float kf[64];
#pragma unroll
                    for (int c = 0; c < 8; ++c) unpack8(*(const u32x4*)(kr + c * 8), kf + c * 8);
                    score = 0.f;
#pragma unroll
                    for (int hh = 0; hh < 8; ++hh) { float dot = 0.f;
#pragma unroll
                        for (int d = 0; d < 64; ++d) dot += kf[d] * qs[hh * 64 + d];
                        score += wsm[hh] * fmaxf(dot, 0.f); } }
            }
            sc[s] = score;
        }
        WAVE_LDS_FENCE();
        const u64 word = select_row(sc, lane);
        mrow[lane] = word;
    }
}
__device__ __forceinline__ void phase_sparse_naive(const Params& p, const Ctx& C) {
    LAS int* list = (LAS int*)(C.lds + C.wave * WSCR); LAS float* qs = (LAS float*)(list + 256);
    const int lane = C.lane;
    const bf16_t* PC = (const bf16_t*)(p.ws + WS_PC);
    for (int qi = C.gw; qi < T; qi += C.ngw) {
        const int t = qi % SEQ, b = qi / SEQ;
        const size_t m = (size_t)b * SEQ + t;
        u64 word = ((const u64*)(p.ws + WS_MASK))[m * 64 + lane];
        int cnt = __popcll(word), off = cnt;
#pragma unroll
        for (int o = 1; o < 64; o <<= 1) { const int v = __shfl_up(off, o); if (lane >= o) off += v; }
        const int total = __builtin_amdgcn_readlane(off, 63); off -= cnt;
        WAVE_LDS_FENCE();
        while (word) { const int bpos = __builtin_ctzll(word); list[off++] = lane * 64 + bpos; word &= word - 1; }
        WAVE_LDS_FENCE();
        for (int h = 0; h < 4; ++h) {
            WAVE_LDS_FENCE();
            qs[lane] = bf2f(PC[m * LD_PC + h * 64 + lane]);
            WAVE_LDS_FENCE();
            const float sl2 = alibi_slope(7 + h) * LOG2E;
            float mx = -INFINITY, l = 0.f, o = 0.f;
            for (int c0 = 0; c0 < total; c0 += 64) {
                const int e = c0 + lane; const bool valid = e < total; const int s = valid ? list[e] : 0; float dot = -INFINITY;
                if (valid) { const bf16_t* kr = PC + ((size_t)b * SEQ + s) * LD_PC + 256 + h * 64; dot = 0.f;
#pragma unroll
                    for (int c = 0; c < 8; ++c) { float f[8]; unpack8(*(const u32x4*)(kr + c * 8), f);
#pragma unroll
                        for (int ee = 0; ee < 8; ++ee) dot += f[ee] * qs[c * 8 + ee]; }
                    dot -= sl2 * (float)(t - s); }
                const float cm = wave_max(dot), mn = fmaxf(mx, cm), al = exp2f(mx - mn), pv = valid ? exp2f(dot - mn) : 0.f;
                l = l * al + wave_sum(pv); o *= al; mx = mn;
                const int nk = min(64, total - c0);
                for (int jj = 0; jj < nk; ++jj) { const float pj = rdlane(pv, jj); const int sj = __builtin_amdgcn_readlane(s, jj);
                    o += pj * bf2f(PC[((size_t)b * SEQ + sj) * LD_PC + 512 + h * 64 + lane]); }
            }
            const int col = 768 + h * 64 + lane;
            const float g = bf2f(((const bf16_t*)(p.ws + WS_PG))[m * LD_PG + col]);
            ((bf16_t*)(p.ws + WS_Y))[m * DM + col] = (bf16_t)f2bf(o / l * silu(g));
        }
    }
}

namespace fa {
typedef float f32x16 __attribute__((ext_vector_type(16)));
typedef short s16x4 __attribute__((ext_vector_type(4)));
typedef short v4i16_t __attribute__((ext_vector_type(4)));
typedef float f32x2_t __attribute__((ext_vector_type(2)));
typedef __bf16 bf16x2_t __attribute__((ext_vector_type(2)));
constexpr float THR = 8.0f;
constexpr float MINIT = -1.0e30f;
constexpr int KSLOT = 12288, VSLOT = 8192;
constexpr int L_K = 0, L_V = 2 * KSLOT, L_WS = L_V + 2 * VSLOT, L_OST = L_WS + NWAVES * 256, L_END = L_OST + NWAVES * 4096;
__device__ __forceinline__ int crow(int r, int hi) { return (r & 3) + 8 * (r >> 2) + 4 * hi; }
__device__ __forceinline__ unsigned cvtpk(float lo, float hi) { f32x2_t v = {lo, hi}; bf16x2_t b = __builtin_convertvector(v, bf16x2_t); return __builtin_bit_cast(unsigned, b); }
__device__ __forceinline__ float max32(float v) { auto rr = __builtin_amdgcn_permlane32_swap(__float_as_uint(v), __float_as_uint(v), false, false); return fmaxf(__uint_as_float(rr[0]), __uint_as_float(rr[1])); }
__device__ __forceinline__ float sum32(float v) { auto rr = __builtin_amdgcn_permlane32_swap(__float_as_uint(v), __float_as_uint(v), false, false); return __uint_as_float(rr[0]) + __uint_as_float(rr[1]); }
#define FA_WAIT_BAR() asm volatile("s_waitcnt vmcnt(0) lgkmcnt(0)\n\ts_barrier" ::: "memory")
#define FA_LDS_WAIT() asm volatile("s_waitcnt lgkmcnt(0)" ::: "memory")
__device__ __forceinline__ void glds16(const void* gsrc, LAS unsigned char* dst_uniform) { __builtin_amdgcn_global_load_lds((const unsigned*)gsrc, (LAS unsigned*)dst_uniform, 16, 0, 0); }
template <int NCH> __device__ __forceinline__ void dma_k(const bf16_t* kptr, LAS unsigned char* kslot, int wid) {
#pragma unroll
    for (int c0 = 0; c0 < NCH; c0 += 8) { const int c = c0 + wid; if (c < NCH) glds16(kptr + c * 8, kslot + c * 1024); }
}
__device__ __forceinline__ void dma_v(const bf16_t* vptr, LAS unsigned char* vslot, int wid) { glds16(vptr, vslot + wid * 1024); }
template <int NKS> __device__ __forceinline__ void qkt(f32x16& p0, f32x16& p1, const LAS unsigned char* kslot, const bf16x8* qr, int r32, int hi) {
    const LAS unsigned char* kb = kslot + hi * 1024 + r32 * 16;
#pragma unroll
    for (int d0 = 0; d0 < NKS; ++d0) {
        const bf16x8 b0 = *(const LAS bf16x8*)(kb + d0 * 2048), b1 = *(const LAS bf16x8*)(kb + d0 * 2048 + 512);
        p0 = __builtin_amdgcn_mfma_f32_32x32x16_bf16(b0, qr[d0], p0, 0, 0, 0);
        p1 = __builtin_amdgcn_mfma_f32_32x32x16_bf16(b1, qr[d0], p1, 0, 0, 0);
    }
}
__device__ __forceinline__ s16x4 vtr(const LAS unsigned char* p) { return __builtin_bit_cast(s16x4, __builtin_amdgcn_ds_read_tr16_b64_v4i16((LAS v4i16_t*)p)); }
struct State { float m, l; f32x16 o[2]; };
__device__ __forceinline__ void init_state(State& s) { s.m = MINIT; s.l = 0.f;
#pragma unroll
    for (int r = 0; r < 16; ++r) { s.o[0][r] = 0.f; s.o[1][r] = 0.f; } }
__device__ __forceinline__ void softmax_pv(State& s, f32x16& p0, f32x16& p1, const LAS unsigned char* vslot, LAS float* wsf, int lane, int r32, int hi) {
    float rm = fmaxf(p0[0], p1[0]);
#pragma unroll
    for (int r = 1; r < 16; ++r) rm = fmaxf(rm, fmaxf(p0[r], p1[r]));
    rm = max32(rm);
    if (__any(rm > s.m + THR)) {
        const float mn = fmaxf(s.m, rm), f = __builtin_amdgcn_exp2f(s.m - mn);
        s.l *= f; s.m = mn;
        FA_LDS_WAIT();
        if (hi == 0) wsf[r32] = f;
        FA_LDS_WAIT();
#pragma unroll
        for (int r = 0; r < 16; ++r) { const float fr = wsf[crow(r, hi)]; s.o[0][r] *= fr; s.o[1][r] *= fr; }
    }
    float sum = 0.f;
#pragma unroll
    for (int r = 0; r < 16; ++r) { p0[r] = __builtin_amdgcn_exp2f(p0[r] - s.m); p1[r] = __builtin_amdgcn_exp2f(p1[r] - s.m); sum += p0[r] + p1[r]; }
    s.l += sum;
    u32x4 pw[4];
#pragma unroll
    for (int k = 0; k < 2; ++k) {
        pw[k]     = (u32x4){cvtpk(p0[8 * k], p0[8 * k + 1]), cvtpk(p0[8 * k + 2], p0[8 * k + 3]), cvtpk(p0[8 * k + 4], p0[8 * k + 5]), cvtpk(p0[8 * k + 6], p0[8 * k + 7])};
        pw[2 + k] = (u32x4){cvtpk(p1[8 * k], p1[8 * k + 1]), cvtpk(p1[8 * k + 2], p1[8 * k + 3]), cvtpk(p1[8 * k + 4], p1[8 * k + 5]), cvtpk(p1[8 * k + 6], p1[8 * k + 7])};
    }
    const LAS unsigned char* vb = vslot + ((lane >> 4) & 1) * 32 + (lane & 3) * 8 + (4 * hi + ((lane & 15) >> 2)) * 64;
#pragma unroll
    for (int dh = 0; dh < 2; ++dh)
#pragma unroll
        for (int ks = 0; ks < 4; ++ks) {
            const s16x4 lo = vtr(vb + dh * 4096 + ks * 1024), hh = vtr(vb + dh * 4096 + ks * 1024 + 512);
            const bf16x8 vf = (bf16x8){lo[0], lo[1], lo[2], lo[3], hh[0], hh[1], hh[2], hh[3]};
            s.o[dh] = __builtin_amdgcn_mfma_f32_32x32x16_bf16(__builtin_bit_cast(bf16x8, pw[ks]), vf, s.o[dh], 0, 0, 0);
        }
}
__device__ __forceinline__ void finish(State& s, LAS float* wsf, LAS bf16_t* stg, int r32, int hi, float* lse2) {
    const float lt = sum32(s.l);
    *lse2 = s.m + __builtin_amdgcn_logf(lt);
    FA_LDS_WAIT();
    if (hi == 0) wsf[32 + r32] = __builtin_amdgcn_rcpf(lt);
    FA_LDS_WAIT();
#pragma unroll
    for (int r = 0; r < 16; ++r) { const int orow = crow(r, hi); const float inv = wsf[32 + orow];
        stg[orow * 64 + r32] = (bf16_t)f2bf(s.o[0][r] * inv); stg[orow * 64 + 32 + r32] = (bf16_t)f2bf(s.o[1][r] * inv); }
    FA_LDS_WAIT();
}
}

__device__ __forceinline__ void mla_unit(const Params& p, LAS unsigned char* lds, int b, int h, int qb, int tid) {
    using namespace fa;
    const int lane = tid & 63, r32 = lane & 31, hi = lane >> 5, wid = __builtin_amdgcn_readfirstlane(tid >> 6);
    const int q0 = qb * 256; const size_t rowbase = (size_t)b * SEQ;
    const bf16_t* QA = (const bf16_t*)(p.ws + WS_QA); const bf16_t* KA = (const bf16_t*)(p.ws + WS_KA); const bf16_t* VA = (const bf16_t*)(p.ws + WS_VA);
    LAS float* wsf = (LAS float*)(lds + L_WS) + wid * 64; LAS bf16_t* stg = (LAS bf16_t*)(lds + L_OST) + wid * 2048;
    const bf16_t* kptr = KA + (rowbase + lane) * LD_KA + h * 96;
    const bf16_t* vptr = VA + (rowbase + 16 * (wid & 3) + (lane >> 2)) * LD_VA + h * 64 + (wid >> 2) * 32 + (lane & 3) * 8;
    const int NT = (q0 + 256) / 64;
    FA_WAIT_BAR();
    dma_k<12>(kptr, lds + L_K, wid); dma_v(vptr, lds + L_V, wid);
    bf16x8 qr[6];
    { const bf16_t* qw = QA + (rowbase + q0 + wid * 32 + r32) * LD_QA + h * 96 + hi * 8;
#pragma unroll
      for (int d0 = 0; d0 < 6; ++d0) qr[d0] = *(const bf16x8*)(qw + d0 * 16); }
    State st; init_state(st);
    const int qmin = q0 + wid * 32, q = qmin + r32;
    for (int t = 0; t < NT; ++t) {
        FA_WAIT_BAR();
        const int sl = t & 1;
        if (t + 1 < NT) { dma_k<12>(kptr + (size_t)(t + 1) * 64 * LD_KA, lds + L_K + (sl ^ 1) * KSLOT, wid); dma_v(vptr + (size_t)(t + 1) * 64 * LD_VA, lds + L_V + (sl ^ 1) * VSLOT, wid); }
        if (64 * t <= qmin + 31) {
            f32x16 p0, p1;
#pragma unroll
            for (int r = 0; r < 16; ++r) { p0[r] = 0.f; p1[r] = 0.f; }
            qkt<6>(p0, p1, lds + L_K + sl * KSLOT, qr, r32, hi);
            if (64 * t + 63 > qmin) {
#pragma unroll
                for (int r = 0; r < 16; ++r) { const int kv = 64 * t + crow(r, hi); if (kv > q) p0[r] = -INFINITY; if (kv + 32 > q) p1[r] = -INFINITY; }
            }
            softmax_pv(st, p0, p1, lds + L_V + sl * VSLOT, wsf, lane, r32, hi);
        }
    }
    float lse2; finish(st, wsf, stg, r32, hi, &lse2);
    const bf16_t* PG = (const bf16_t*)(p.ws + WS_PG); bf16_t* Y = (bf16_t*)(p.ws + WS_Y);
#pragma unroll
    for (int i = 0; i < 4; ++i) { const int row = i * 8 + (lane >> 3), ch = lane & 7; const size_t m = rowbase + q0 + wid * 32 + row;
        float o8[8], g8[8]; unpack8(*(const LAS u32x4*)(stg + row * 64 + ch * 8), o8); unpack8(*(const u32x4*)(PG + m * LD_PG + h * 64 + ch * 8), g8);
        u32x4 w; w.x = pk2(o8[0] * silu(g8[0]), o8[1] * silu(g8[1])); w.y = pk2(o8[2] * silu(g8[2]), o8[3] * silu(g8[3]));
        w.z = pk2(o8[4] * silu(g8[4]), o8[5] * silu(g8[5])); w.w = pk2(o8[6] * silu(g8[6]), o8[7] * silu(g8[7]));
        *(u32x4*)(Y + m * DM + h * 64 + ch * 8) = w; }
}
__device__ __forceinline__ void phase_mla(const Params& p, const Ctx& C) {
    const int G = gridDim.x, bx = blockIdx.x, vcu = (G % 8 == 0) ? (bx % 8) * (G / 8) + bx / 8 : bx;
    for (int v = vcu; v < 256; v += G) {
        const int g = v >> 4, i = v & 15;
#pragma unroll 1
        for (int j = 0; j < 3; ++j) {
            const int bh = 3 * g + j, qb = (j == 0) ? i : (j == 1) ? ((i + 8) & 15) : (i < 8 ? 15 - 2 * i : 30 - 2 * i);
            mla_unit(p, C.lds, bh / 6, bh % 6, qb, C.tid);
        }
    }
    __syncthreads();
}

__device__ __forceinline__ void sparse_unit(const Params& p, LAS unsigned char* lds, int b, int h, int qb, int tid) {
    using namespace fa;
    const int lane = tid & 63, r32 = lane & 31, hi = lane >> 5, wid = __builtin_amdgcn_readfirstlane(tid >> 6);
    const int q0 = qb * 256; const size_t rowbase = (size_t)b * SEQ;
    const bf16_t* PC = (const bf16_t*)(p.ws + WS_PC);
    LAS float* wsf = (LAS float*)(lds + L_WS) + wid * 64; LAS bf16_t* stg = (LAS bf16_t*)(lds + L_OST) + wid * 2048;
    const bf16_t* kptr = PC + (rowbase + lane) * LD_PC + 256 + h * 64;
    const bf16_t* vptr = PC + (rowbase + 16 * (wid & 3) + (lane >> 2)) * LD_PC + 512 + h * 64 + (wid >> 2) * 32 + (lane & 3) * 8;
    const int NT = (q0 + 256) / 64;
    FA_WAIT_BAR();
    dma_k<8>(kptr, lds + L_K, wid); dma_v(vptr, lds + L_V, wid);
    const int qmin = q0 + wid * 32, q = qmin + r32;
    bf16x8 qr[4];
    { const bf16_t* qw = PC + (rowbase + q) * LD_PC + h * 64 + hi * 8;
#pragma unroll
      for (int d0 = 0; d0 < 4; ++d0) qr[d0] = *(const bf16x8*)(qw + d0 * 16); }
    const u64* mrow = (const u64*)(p.ws + WS_MASK) + (rowbase + q) * 64;
    const float sl2 = exp2f(-0.8f * (float)(7 + h)) * LOG2E;
    State st; init_state(st);
    const int nact = (qmin + 31) / 64 + 1;
    u64 wcur = mrow[0];
    for (int t = 0; t < NT; ++t) {
        FA_WAIT_BAR();
        const int sl = t & 1;
        if (t + 1 < NT) { dma_k<8>(kptr + (size_t)(t + 1) * 64 * LD_PC, lds + L_K + (sl ^ 1) * KSLOT, wid); dma_v(vptr + (size_t)(t + 1) * 64 * LD_PC, lds + L_V + (sl ^ 1) * VSLOT, wid); }
        if (t < nact) {
            const u64 wnext = (t + 1 < nact) ? mrow[t + 1] : 0ull;
            if (__any(wcur != 0ull)) {
                const unsigned wl = (unsigned)wcur >> (4 * hi), wh = (unsigned)(wcur >> 32) >> (4 * hi);
                const float base = sl2 * (float)(64 * t + 4 * hi - q);
                f32x16 p0, p1;
#pragma unroll
                for (int r = 0; r < 16; ++r) { const int cr = (r & 3) + 8 * (r >> 2);
                    p0[r] = (wl & (1u << cr)) ? fmaf(sl2, (float)cr, base) : -INFINITY;
                    p1[r] = (wh & (1u << cr)) ? fmaf(sl2, (float)(cr + 32), base) : -INFINITY; }
                qkt<4>(p0, p1, lds + L_K + sl * KSLOT, qr, r32, hi);
                softmax_pv(st, p0, p1, lds + L_V + sl * VSLOT, wsf, lane, r32, hi);
            }
            wcur = wnext;
        }
    }
    float lse2; finish(st, wsf, stg, r32, hi, &lse2);
    const bf16_t* PG = (const bf16_t*)(p.ws + WS_PG); bf16_t* Y = (bf16_t*)(p.ws + WS_Y);
#pragma unroll
    for (int i = 0; i < 4; ++i) { const int row = i * 8 + (lane >> 3), ch = lane & 7; const size_t m = rowbase + q0 + wid * 32 + row;
        float o8[8], g8[8]; unpack8(*(const LAS u32x4*)(stg + row * 64 + ch * 8), o8); unpack8(*(const u32x4*)(PG + m * LD_PG + 768 + h * 64 + ch * 8), g8);
        u32x4 w; w.x = pk2(o8[0] * silu(g8[0]), o8[1] * silu(g8[1])); w.y = pk2(o8[2] * silu(g8[2]), o8[3] * silu(g8[3]));
        w.z = pk2(o8[4] * silu(g8[4]), o8[5] * silu(g8[5])); w.w = pk2(o8[6] * silu(g8[6]), o8[7] * silu(g8[7]));
        *(u32x4*)(Y + m * DM + 768 + h * 64 + ch * 8) = w; }
}
__device__ __forceinline__ void phase_sparse(const Params& p, const Ctx& C) {
    const int G = gridDim.x, bx = blockIdx.x, vcu = (G % 8 == 0) ? (bx % 8) * (G / 8) + bx / 8 : bx;
    for (int v = vcu; v < 256; v += G) {
        const int bh = v >> 3, i = v & 7;
        sparse_unit(p, C.lds, bh >> 2, bh & 3, i, C.tid);
        sparse_unit(p, C.lds, bh >> 2, bh & 3, 15 - i, C.tid);
    }
    __syncthreads();
}

constexpr unsigned NEGKEY = 0x007FFFFFu;
__device__ __forceinline__ u64 select256(const unsigned (&u)[64], int lane) {
    unsigned thr = 0u; int cge = 0;
    for (int bit = 31; bit >= 0; --bit) {
        const unsigned cand = thr | (1u << bit); int c = 0;
#pragma unroll
        for (int r = 0; r < 64; ++r) c += __popcll(__ballot(u[r] >= cand));
        if (c >= 256) { thr = cand; cge = c; if (c == 256) break; }
    }
    unsigned mlo = 0u, mhi = 0u;
    if (cge == 256) {
#pragma unroll
        for (int r = 0; r < 64; ++r) { const u64 word = __ballot(u[r] >= thr);
            if (lane == r) { mlo = (unsigned)word; mhi = (unsigned)(word >> 32); } }
    } else {
        int cgt = 0;
#pragma unroll
        for (int r = 0; r < 64; ++r) cgt += __popcll(__ballot(u[r] > thr));
        const int need = 256 - cgt; int run = 0;
        const u64 ltmask = (lane == 0) ? 0ull : (~0ull >> (64 - lane));
#pragma unroll
        for (int r = 0; r < 64; ++r) {
            const bool gt = u[r] > thr, eq = u[r] == thr;
            const u64 beq = __ballot(eq);
            const int pos = run + __popcll(beq & ltmask);
            const u64 word = __ballot(gt || (eq && pos < need));
            run += __popcll(beq);
            if (lane == r) { mlo = (unsigned)word; mhi = (unsigned)(word >> 32); }
        }
    }
    return (u64)mlo | ((u64)mhi << 32);
}
__device__ __forceinline__ void idx_unit(const Params& p, LAS unsigned char* lds, int b, int g, int tid) {
    typedef float f32x16 __attribute__((ext_vector_type(16)));
    const int lane = tid & 63, r32 = lane & 31, hi = lane >> 5, wid = __builtin_amdgcn_readfirstlane(tid >> 6);
    const int t0 = g * 8; const size_t rowbase = (size_t)b * SEQ;
    u64* mask = (u64*)(p.ws + WS_MASK);
    const int t = t0 + wid;
    if (t0 < 256) {
        const int lo = lane * 64; u64 word = 0ull;
        if (t >= lo + 63) word = ~0ull; else if (t >= lo) word = (~0ull) >> (63 - (t - lo));
        mask[(rowbase + t) * 64 + lane] = word; return;
    }
    const bf16_t* PI = (const bf16_t*)(p.ws + WS_PI); const bf16_t* PB = (const bf16_t*)(p.ws + WS_PB);
    LAS float* sc = (LAS float*)lds;
    bf16x8 aq[2][4];
    { const int ql = 2 * ((r32 >> 2) & 1) + (r32 >> 4), hd = 4 * ((r32 >> 3) & 1) + (r32 & 3);
#pragma unroll
      for (int rt = 0; rt < 2; ++rt) { const bf16_t* qp = PI + (rowbase + t0 + 4 * rt + ql) * LD_PI + hd * 64 + hi * 8;
#pragma unroll
          for (int ks = 0; ks < 4; ++ks) aq[rt][ks] = *(const bf16x8*)(qp + ks * 16); } }
    float wq[2][16];
#pragma unroll
    for (int rt = 0; rt < 2; ++rt)
#pragma unroll
        for (int qs = 0; qs < 2; ++qs) unpack8(*(const u32x4*)(PB + (rowbase + t0 + 4 * rt + 2 * hi + qs) * LD_PB + PB_WI), &wq[rt][8 * qs]);
    const int nkt = (t0 + 8 + 31) >> 5;
    const bf16_t* kp = PB + (rowbase + r32) * LD_PB + PB_KI + hi * 8;
    bf16x8 kb[4];
    if (wid < nkt) {
#pragma unroll
        for (int ks = 0; ks < 4; ++ks) kb[ks] = *(const bf16x8*)(kp + (size_t)wid * 32 * LD_PB + ks * 16); }
    for (int kt = wid; kt < nkt; kt += 8) {
        bf16x8 kn[4];
        if (kt + 8 < nkt) {
#pragma unroll
            for (int ks = 0; ks < 4; ++ks) kn[ks] = *(const bf16x8*)(kp + (size_t)(kt + 8) * 32 * LD_PB + ks * 16); }
        else {
#pragma unroll
            for (int ks = 0; ks < 4; ++ks) kn[ks] = kb[ks]; }
#pragma unroll
        for (int rt = 0; rt < 2; ++rt) {
            f32x16 acc;
#pragma unroll
            for (int r = 0; r < 16; ++r) acc[r] = 0.f;
#pragma unroll
            for (int ks = 0; ks < 4; ++ks) acc = __builtin_amdgcn_mfma_f32_32x32x16_bf16(aq[rt][ks], kb[ks], acc, 0, 0, 0);
            float s0 = 0.f, s1 = 0.f;
#pragma unroll
            for (int r = 0; r < 8; ++r) { s0 = fmaf(wq[rt][r], fmaxf(acc[r], 0.f), s0); s1 = fmaf(wq[rt][8 + r], fmaxf(acc[8 + r], 0.f), s1); }
            const int key = kt * 32 + r32;
            sc[(4 * rt + 2 * hi) * 4096 + key] = s0; sc[(4 * rt + 2 * hi + 1) * 4096 + key] = s1;
        }
#pragma unroll
        for (int ks = 0; ks < 4; ++ks) kb[ks] = kn[ks];
    }
    __syncthreads();
    {
        unsigned u[64];
        const LAS float* row = sc + wid * 4096;
#pragma unroll
        for (int r = 0; r < 64; ++r) { const int idx = 64 * r + lane; u[r] = (idx <= t) ? fkey(row[idx]) : NEGKEY; }
        const u64 word = select256(u, lane);
        mask[(rowbase + t) * 64 + lane] = word;
    }
    __syncthreads();
}
__device__ __forceinline__ void phase_idx(const Params& p, const Ctx& C) {
    const int G = gridDim.x, bx = blockIdx.x, vcu = (G % 8 == 0) ? (bx % 8) * (G / 8) + bx / 8 : bx;
    for (int v = vcu; v < 256; v += G) {
        const int b = v >> 5, k = v & 31;
#pragma unroll 1
        for (int j = 0; j < 16; ++j) idx_unit(p, C.lds, b, ((j & 1) ? 31 - k : k) + 32 * j, C.tid);
    }
    __syncthreads();
}

constexpr size_t WS_LSE = WS_PART + (size_t)3 * T * 384 * 2;
constexpr int DL_K = 0, DL_V = 6 * 8192, DL_WS = 12 * 8192, DL_OST = DL_WS + NWAVES * 256, DL_END = DL_OST + NWAVES * 4096;
__device__ __forceinline__ void dil_unit(const Params& p, LAS unsigned char* lds, int uid, int tid) {
    using namespace fa;
    const int lane = tid & 63, r32 = lane & 31, hi = lane >> 5, wid = __builtin_amdgcn_readfirstlane(tid >> 6);
    const int k16 = uid & 15, pi = (uid >> 4) % 3, bh = uid / 48, b = bh / 6, h = bh % 6;
    const int d = (pi == 0) ? 1 : (pi == 1) ? 4 : 16, nblk = 16 / d, res = k16 / nblk, j = k16 % nblk;
    const size_t rowbase = (size_t)b * SEQ;
    const bf16_t* PB = (const bf16_t*)(p.ws + WS_PB);
    LAS float* wsf = (LAS float*)(lds + DL_WS) + wid * 64; LAS bf16_t* stg = (LAS bf16_t*)(lds + DL_OST) + wid * 2048;
    const int base = 256 * j - 128;
    FA_WAIT_BAR();
#pragma unroll
    for (int u = 0; u < 6; ++u) {
        int ik = base + 64 * u + lane; ik = ik < 0 ? 0 : ik;
        dma_k<8>(PB + (rowbase + res + d * ik) * LD_PB + PB_KB + h * 64, lds + DL_K + u * 8192, wid);
        int iv = base + 64 * u + 16 * (wid & 3) + (lane >> 2); iv = iv < 0 ? 0 : iv;
        dma_v(PB + (rowbase + res + d * iv) * LD_PB + PB_VB + h * 64 + (wid >> 2) * 32 + (lane & 3) * 8, lds + DL_V + u * 8192, wid);
    }
    const int iq = 256 * j + 32 * wid + r32; const size_t mq = rowbase + res + d * iq;
    bf16x8 qr[4];
    { const bf16_t* qw = PB + mq * LD_PB + PB_QB + h * 64 + hi * 8;
#pragma unroll
      for (int d0 = 0; d0 < 4; ++d0) qr[d0] = *(const bf16x8*)(qw + d0 * 16); }
    const float sld = exp2f(-0.8f * (float)(h + 1)) * LOG2E * (float)d;
    const unsigned lim = (unsigned)(iq < 128 ? iq : 128);
    State st; init_state(st);
    FA_WAIT_BAR();
#pragma unroll 1
    for (int uu = 0; uu < 3; ++uu) {
        const int u = (wid >> 1) + uu;
        if (base + 64 * u + 63 < 0) continue;
        const int e0 = iq - base - 64 * u - 4 * hi;
        f32x16 p0, p1;
#pragma unroll
        for (int r = 0; r < 16; ++r) { const int cr = (r & 3) + 8 * (r >> 2); const int d0 = e0 - cr, d1 = e0 - cr - 32;
            p0[r] = ((unsigned)d0 <= lim) ? -sld * (float)d0 : -INFINITY;
            p1[r] = ((unsigned)d1 <= lim) ? -sld * (float)d1 : -INFINITY; }
        qkt<4>(p0, p1, lds + DL_K + u * 8192, qr, r32, hi);
        softmax_pv(st, p0, p1, lds + DL_V + u * 8192, wsf, lane, r32, hi);
    }
    float lse2; finish(st, wsf, stg, r32, hi, &lse2);
    bf16_t* PART = (bf16_t*)(p.ws + WS_PART) + (size_t)pi * T * 384; float* LSE = (float*)(p.ws + WS_LSE) + (size_t)pi * T * 6;
    if (hi == 0) LSE[mq * 6 + h] = lse2;
#pragma unroll
    for (int i = 0; i < 4; ++i) { const int row = i * 8 + (lane >> 3), ch = lane & 7; const size_t m = rowbase + res + d * (256 * j + 32 * wid + row);
        *(u32x4*)(PART + m * 384 + h * 64 + ch * 8) = *(const LAS u32x4*)(stg + row * 64 + ch * 8); }
}
__device__ __forceinline__ void phase_dil(const Params& p, const Ctx& C) {
    const int G = gridDim.x, bx = blockIdx.x, vcu = (G % 8 == 0) ? (bx % 8) * (G / 8) + bx / 8 : bx;
    for (int uid = vcu * 9; uid < 2304; uid += G * 9) {
#pragma unroll 1
        for (int k = 0; k < 9; ++k) dil_unit(p, C.lds, uid + k, C.tid);
    }
    __syncthreads();
}
__device__ __forceinline__ void phase_dilcombine(const Params& p, const Ctx& C) {
    const bf16_t* PART = (const bf16_t*)(p.ws + WS_PART); const float* LSE = (const float*)(p.ws + WS_LSE);
    const bf16_t* PG = (const bf16_t*)(p.ws + WS_PG); bf16_t* Y = (bf16_t*)(p.ws + WS_Y);
    for (int e = blockIdx.x * NTHREADS + C.tid; e < T * 48; e += gridDim.x * NTHREADS) {
        const int m = e / 48, c = e % 48, h = c >> 3;
        const float l0 = LSE[(size_t)m * 6 + h], l1 = LSE[((size_t)T + m) * 6 + h], l2 = LSE[((size_t)2 * T + m) * 6 + h];
        const float mx = fmaxf(l0, fmaxf(l1, l2));
        float w0 = exp2f(l0 - mx), w1 = exp2f(l1 - mx), w2 = exp2f(l2 - mx); const float inv = 1.0f / (w0 + w1 + w2); w0 *= inv; w1 *= inv; w2 *= inv;
        float a[8], bb[8], cc[8], g[8];
        unpack8(*(const u32x4*)(PART + (size_t)m * 384 + c * 8), a); unpack8(*(const u32x4*)(PART + ((size_t)T + m) * 384 + c * 8), bb); unpack8(*(const u32x4*)(PART + ((size_t)2 * T + m) * 384 + c * 8), cc);
        unpack8(*(const u32x4*)(PG + (size_t)m * LD_PG + 384 + c * 8), g);
        float y[8];
#pragma unroll
        for (int i = 0; i < 8; ++i) y[i] = (w0 * a[i] + w1 * bb[i] + w2 * cc[i]) * silu(g[i]);
        u32x4 o; o.x = pk2(y[0], y[1]); o.y = pk2(y[2], y[3]); o.z = pk2(y[4], y[5]); o.w = pk2(y[6], y[7]);
        *(u32x4*)(Y + (size_t)m * DM + 384 + c * 8) = o;
    }
}

__global__ void __launch_bounds__(NTHREADS, 2) mega(Params p) {
    extern __shared__ __attribute__((aligned(16))) unsigned char lds_raw[];
    cg::grid_group grid = cg::this_grid();
    LAS unsigned char* lds = (LAS unsigned char*)lds_raw;
#define GRID_SYNC() do { __syncthreads(); grid.sync(); } while (0)
#define CX fresh_ctx(lds)
    phase_prologue(p, CX); GRID_SYNC();
    phase_makeh(p, CX); GRID_SYNC();
    for (int l = 0; l < DEPTH; ++l) {
        phase_gemm<0>(p, CX, l); GRID_SYNC();
        phase_rowstat(p, CX); GRID_SYNC();
        phase_gemm<1>(p, CX, l); phase_gemm<2>(p, CX, l); phase_krope(p, CX); __syncthreads();
        phase_idx(p, CX); phase_dil(p, CX); GRID_SYNC();
        phase_dilcombine(p, CX); phase_mla(p, CX); phase_sparse(p, CX); GRID_SYNC();
        phase_gemm<3>(p, CX, l); GRID_SYNC();
        phase_ln(p, CX, l); if (l + 1 < DEPTH) GRID_SYNC();
    }
}

extern "C" void kernel_launch(void* const* d_in, const int* in_sizes, int n_in, void* d_out, int out_size, void* d_ws, size_t ws_size, hipStream_t stream) {
    static int grid = 0;
    if (grid == 0) {
        if (n_in != 13 || in_sizes[0] != T * DM || out_size != T * DM || ws_size < WS_END) { fprintf(stderr, "kernel_launch: unexpected shapes (n_in %d, in0 %d, out %d, ws %zu)\n", n_in, n_in > 0 ? in_sizes[0] : -1, out_size, ws_size); grid = -1; return; }
        int dev = 0, cus = 0, per_cu = 0;
        if (hipGetDevice(&dev) != hipSuccess || hipDeviceGetAttribute(&cus, hipDeviceAttributeMultiprocessorCount, dev) != hipSuccess) { fprintf(stderr, "kernel_launch: device query failed\n"); grid = -1; return; }
        if (hipFuncSetAttribute((const void*)mega, hipFuncAttributeMaxDynamicSharedMemorySize, LDS_BYTES) != hipSuccess) { fprintf(stderr, "kernel_launch: hipFuncSetAttribute failed\n"); grid = -1; return; }
        if (hipOccupancyMaxActiveBlocksPerMultiprocessor(&per_cu, (const void*)mega, NTHREADS, LDS_BYTES) != hipSuccess || per_cu < 1) { fprintf(stderr, "kernel_launch: occupancy query says %d blocks/CU\n", per_cu); grid = -1; return; }
        grid = cus;
        if (grid < MOD_ITEMS) { fprintf(stderr, "kernel_launch: grid %d too small\n", grid); grid = -1; return; }
    }
    if (grid < 0) return;
    Params p{};
    p.x = (const float*)d_in[0]; p.c = (const float*)d_in[1]; p.w_ada = (const float*)d_in[2]; p.b_ada = (const float*)d_in[3]; p.w_in = (const float*)d_in[4];
    p.qg = (const float*)d_in[5]; p.kvg = (const float*)d_in[6]; p.w_uq = (const float*)d_in[7]; p.w_uk = (const float*)d_in[8]; p.w_uv = (const float*)d_in[9];
    p.w_out = (const float*)d_in[10]; p.ln_g = (const float*)d_in[11]; p.ln_b = (const float*)d_in[12];
    p.out = (float*)d_out; p.ws = (unsigned char*)d_ws; p.layer = 0; p.pad = 0;
    void* args[] = {&p};
    hipError_t e = hipLaunchCooperativeKernel((const void*)mega, dim3(grid), dim3(NTHREADS), args, LDS_BYTES, stream);
    if (e != hipSuccess) fprintf(stderr, "kernel_launch: cooperative launch failed: %s (grid %d)\n", hipGetErrorString(e), grid);
}
```

```cpp
#include <hip/hip_runtime.h>
#include <cstdio>
#include <cstdint>
#include <hip/hip_cooperative_groups.h>
namespace cg = cooperative_groups;

#define LAS __attribute__((address_space(3)))
typedef unsigned short bf16_t;
typedef short bf16x8 __attribute__((ext_vector_type(8)));
typedef float f32x4 __attribute__((ext_vector_type(4)));
typedef unsigned u32x4 __attribute__((ext_vector_type(4)));
typedef unsigned long long u64;

constexpr int NB = 8, SEQ = 4096, DM = 1024, T = NB * SEQ, DEPTH = 2;
constexpr int INW = 4584, NIN = 4608;
constexpr int LD_PA = 1024, LD_PB = 1160, LD_PC = 768, LD_PI = 512, LD_PG = 1024;
constexpr int PB_QB = 0, PB_KB = 384, PB_VB = 768, PB_WI = 1152;
constexpr int LD_QA = 576, LD_KA = 576, LD_VA = 384;
constexpr float LOG2E = 1.4426950408889634f;
constexpr float QSC64 = 0.125f * LOG2E;
constexpr float QSC96 = 0.10206207261596575f * LOG2E;
constexpr float ALPHA = 1.4142135623730951f;

constexpr size_t MiB = 1u << 20;
constexpr size_t WS_CTL = 0;
constexpr size_t WS_MOD = 1 * MiB;
constexpr size_t WS_ROPE = 1 * MiB + 256 * 1024;
constexpr size_t WS_WIN = 2 * MiB;
constexpr size_t WS_WUQ = 20 * MiB;
constexpr size_t WS_WUKV = 23 * MiB;
constexpr size_t WS_WOUT = 24 * MiB;
constexpr size_t WS_H = 28 * MiB;
constexpr size_t WS_QA = 28 * MiB, WS_VA = 64 * MiB;
constexpr size_t WS_PA = 92 * MiB;
constexpr size_t WS_Y = 92 * MiB;
constexpr size_t WS_PB = 156 * MiB;
constexpr size_t WS_KI2 = 230 * MiB;
constexpr size_t WS_PC = 236 * MiB;
constexpr size_t WS_PI = 284 * MiB;
constexpr size_t WS_PG = 316 * MiB;
constexpr size_t WS_KA = 380 * MiB;
constexpr size_t WS_MASK = 416 * MiB;
constexpr size_t WS_PART = 432 * MiB;
constexpr size_t WS_SSQ = 507 * MiB;
constexpr size_t WS_END = 509 * MiB;

__device__ __forceinline__ float bf2f(unsigned u) { return __uint_as_float(u << 16); }
__device__ __forceinline__ unsigned f2bf(float f) { unsigned u = __float_as_uint(f); return (u + 0x7fffu + ((u >> 16) & 1u)) >> 16; }
__device__ __forceinline__ unsigned pk2(float lo, float hi) { return f2bf(lo) | (f2bf(hi) << 16); }
__device__ __forceinline__ float silu(float x) { return x / (1.0f + __expf(-x)); }
__device__ __forceinline__ float wave_sum(float v) {
#pragma unroll
    for (int o = 1; o < 64; o <<= 1) v += __shfl_xor(v, o);
    return v;
}
__device__ __forceinline__ float wave_max(float v) {
#pragma unroll
    for (int o = 1; o < 64; o <<= 1) v = fmaxf(v, __shfl_xor(v, o));
    return v;
}
__device__ __forceinline__ int wave_sum_i(int v) {
#pragma unroll
    for (int o = 1; o < 64; o <<= 1) v += __shfl_xor(v, o);
    return v;
}
__device__ __forceinline__ void unpack8(const u32x4 v, float* f) {
    f[0] = bf2f(v.x & 0xffffu); f[1] = __uint_as_float(v.x & 0xffff0000u);
    f[2] = bf2f(v.y & 0xffffu); f[3] = __uint_as_float(v.y & 0xffff0000u);
    f[4] = bf2f(v.z & 0xffffu); f[5] = __uint_as_float(v.z & 0xffff0000u);
    f[6] = bf2f(v.w & 0xffffu); f[7] = __uint_as_float(v.w & 0xffff0000u);
}

namespace pg8 {
constexpr int BM = 256, BK = 64, HALF = 128, HTB = HALF * BK * 2, STAGE_BYTES = 8 * HTB, NXCD = 8, WGM = 8;
__host__ __device__ __forceinline__ int lds_byte(int r, int c) { const int st = (r >> 4) * 2 + (c >> 5), rr = r & 15, cc = c & 31, ob = rr * 64 + cc * 2; return st * 1024 + (ob ^ (((ob >> 9) & 1) << 5)); }
__host__ __device__ __forceinline__ void stage_rc(int b, int& R, int& C) { const int st = b / 1024, sb = b % 1024, swz = sb ^ (((sb >> 9) & 1) << 5); R = (st >> 1) * 16 + swz / 64; C = (st & 1) * 32 + (swz % 64) / 2; }
__host__ __device__ __forceinline__ int perm32(int rho) { const int n = rho >> 4, i = rho & 15; return 8 * (i >> 2) + 4 * n + (i & 3); }

struct Unit { int pm, pn; };
struct Gemm { const bf16_t* A; const bf16_t* Bt; int M, N, K, lda, ldb; };

struct StaticOrder {
    int nM, nN, nwg, G, c;
    __host__ __device__ void init(int M, int N, int G_, int c_) { nM = M / BM; nN = N / BM; nwg = nM * nN; G = G_; c = c_; }
    __host__ __device__ bool next(int i, Unit& u) const {
        const long L = (long)i * G + c; if (L >= nwg) return false;
        int wgid = (int)L; { const int q = nwg / NXCD, r = nwg % NXCD, xcd = wgid % NXCD, off = wgid / NXCD; wgid = (xcd < r ? xcd * (q + 1) : r * (q + 1) + (xcd - r) * q) + off; }
        const int nig = WGM * nN, gid = wgid / nig, fm = gid * WGM, gsz = (nM - fm) < WGM ? (nM - fm) : WGM;
        u.pm = fm + ((wgid % nig) % gsz); u.pn = (wgid % nig) / gsz; return true;
    }
};

template <class F> struct EpiChunk {
    static constexpr bool PERM = true;
    F f;
    __device__ __forceinline__ void operator()(const f32x4 (&acc)[2][2][4][2], const Unit& u, int wr, int wc, int fr, int fq) const {
        const int row0 = u.pm * BM + wr * 64 + fr, col0 = u.pn * BM + wc * 32 + 8 * fq;
#pragma unroll
        for (int ai = 0; ai < 2; ++ai)
#pragma unroll
            for (int m = 0; m < 4; ++m) { const int row = row0 + ai * HALF + m * 16; const float rs = f.row(row);
#pragma unroll
                for (int bj = 0; bj < 2; ++bj) f(row, col0 + bj * HALF, acc[ai][bj][m][0], acc[ai][bj][m][1], rs);
                asm volatile("" ::: "memory"); }
    }
};

template <class Epi, class Sched, bool ALIGN_EPI>
__device__ __forceinline__ void gemm_phase(LAS unsigned char* lds, const Gemm g, const Sched& S, const Epi& E, int tid) {
    asm volatile("" : "+v"(tid));
    const int wid = __builtin_amdgcn_readfirstlane(tid >> 6), lane = tid & 63, wr = wid >> 2, wc = wid & 3, fr = lane & 15, fq = lane >> 4;
    const int K = g.K, nt = K / BK;
    unsigned voffA[2], voffB[2];
#pragma unroll
    for (int i = 0; i < 2; ++i) { int R, C; stage_rc(tid * 16 + i * 8192, R, C); const int Rb = Epi::PERM ? ((R & ~31) + perm32(R & 31)) : R;
        voffA[i] = (unsigned)(R * g.lda + C) * 2u; voffB[i] = (unsigned)(Rb * g.ldb + C) * 2u; }
    const size_t kstep = (size_t)(BK * 2);
    const size_t hsA = (size_t)HALF * g.lda * 2, hsB = (size_t)HALF * g.ldb * 2;
    const size_t tsA = 2 * hsA, tsB = 2 * hsB;
    const unsigned ldsw = (unsigned)wid * 1024u;
    const int aoff = lds_byte(wr * 64 + fr, fq * 8), boff = lds_byte(wc * 32 + fr, fq * 8);
#define PG8_SA(b, h) (((b) * 2 + (h)) * HTB)
#define PG8_SB(b, h) ((4 + (b) * 2 + (h)) * HTB)
#define PG8_STAGE(bufoff, gbase, voff) do { _Pragma("unroll") for (int _i = 0; _i < 2; ++_i) \
        __builtin_amdgcn_global_load_lds((const unsigned*)((const char*)(gbase) + (voff)[_i]), (LAS unsigned*)(lds + (bufoff) + ldsw + _i * 8192), 16, 0, 0); } while (0)
#define PG8_LDA(dst, b, h) do { _Pragma("unroll") for (int m = 0; m < 4; ++m) _Pragma("unroll") for (int k = 0; k < 2; ++k) dst[m][k] = *(const LAS bf16x8*)(lds + PG8_SA(b, h) + aoff + m * 2048 + k * 1024); } while (0)
#define PG8_LDB(dst, b, h) do { _Pragma("unroll") for (int n = 0; n < 2; ++n) _Pragma("unroll") for (int k = 0; k < 2; ++k) dst[n][k] = *(const LAS bf16x8*)(lds + PG8_SB(b, h) + boff + n * 2048 + k * 1024); } while (0)
#define PG8_MMA(ai, bj, At, Bt) do { __builtin_amdgcn_s_setprio(1); _Pragma("unroll") for (int m = 0; m < 4; ++m) _Pragma("unroll") for (int n = 0; n < 2; ++n) _Pragma("unroll") for (int k = 0; k < 2; ++k) \
        acc[ai][bj][m][n] = __builtin_amdgcn_mfma_f32_16x16x32_bf16(Bt[n][k], At[m][k], acc[ai][bj][m][n], 0, 0, 0); __builtin_amdgcn_s_setprio(0); } while (0)
#define PG8_WAIT_V(n) asm volatile("s_waitcnt vmcnt(" #n ")" ::: "memory")
#define PG8_WAIT_L(n) asm volatile("s_waitcnt lgkmcnt(" #n ")" ::: "memory")
#define PG8_BAR __builtin_amdgcn_s_barrier()
#define PG8_SCHED __builtin_amdgcn_sched_barrier(0)
    Unit cur, nxt; int ui = 0;
    if (!S.next(0, cur)) return;
    f32x4 acc[2][2][4][2];
#pragma unroll
    for (int a = 0; a < 2; ++a)
#pragma unroll
        for (int b = 0; b < 2; ++b)
#pragma unroll
            for (int m = 0; m < 4; ++m)
#pragma unroll
                for (int n = 0; n < 2; ++n) acc[a][b][m][n] = (f32x4){0.f, 0.f, 0.f, 0.f};
    bf16x8 At[4][2], B0[2][2], B1[2][2];
    const char* cA = (const char*)g.A + (size_t)cur.pm * tsA; const char* cB = (const char*)g.Bt + (size_t)cur.pn * tsB;
    PG8_STAGE(PG8_SB(0, 0), cB, voffB); PG8_STAGE(PG8_SB(0, 1), cB + hsB, voffB); PG8_STAGE(PG8_SA(0, 0), cA, voffA); PG8_STAGE(PG8_SA(0, 1), cA + hsA, voffA);
    if (wr == 1) PG8_BAR;
    PG8_WAIT_V(2); PG8_BAR;
    PG8_STAGE(PG8_SB(1, 0), cB + kstep, voffB); PG8_STAGE(PG8_SA(1, 0), cA + kstep, voffA); PG8_STAGE(PG8_SB(1, 1), cB + hsB + kstep, voffB);
    PG8_WAIT_V(6); PG8_BAR;
    for (;;) {
        const bool has_next = S.next(ui + 1, nxt);
        const char* nA = has_next ? (const char*)g.A + (size_t)nxt.pm * tsA : cA; const char* nB = has_next ? (const char*)g.Bt + (size_t)nxt.pn * tsB : cB;
#pragma nounroll
        for (int t = 0; t < nt; t += 2) {
            const bool last = (t == nt - 2);
            const char* a1 = cA + (size_t)(t + 1) * kstep;
            const char* a2 = last ? nA : cA + (size_t)(t + 2) * kstep; const char* b2 = last ? nB : cB + (size_t)(t + 2) * kstep;
            const char* a3 = a2 + kstep; const char* b3 = b2 + kstep;
            PG8_LDB(B0, 0, 0); PG8_LDB(B1, 0, 1); PG8_SCHED; PG8_LDA(At, 0, 0); PG8_STAGE(PG8_SA(1, 1), a1 + hsA, voffA);
            PG8_WAIT_V(8); PG8_WAIT_L(0); PG8_BAR; PG8_MMA(0, 0, At, B0); PG8_MMA(0, 1, At, B1); PG8_BAR; PG8_SCHED;
            PG8_LDA(At, 0, 1); PG8_STAGE(PG8_SB(0, 0), b2, voffB); PG8_STAGE(PG8_SB(0, 1), b2 + hsB, voffB); PG8_STAGE(PG8_SA(0, 0), a2, voffA);
            PG8_WAIT_V(8); PG8_WAIT_L(0); PG8_BAR; PG8_MMA(1, 0, At, B0); PG8_MMA(1, 1, At, B1); PG8_BAR; PG8_SCHED;
            PG8_LDB(B0, 1, 0); PG8_LDB(B1, 1, 1); PG8_SCHED; PG8_LDA(At, 1, 0); PG8_STAGE(PG8_SA(0, 1), a2 + hsA, voffA);
            PG8_WAIT_V(8); PG8_WAIT_L(0); PG8_BAR; PG8_MMA(0, 0, At, B0); PG8_MMA(0, 1, At, B1); PG8_BAR; PG8_SCHED;
            PG8_LDA(At, 1, 1); PG8_STAGE(PG8_SB(1, 0), b3, voffB); PG8_STAGE(PG8_SB(1, 1), b3 + hsB, voffB); PG8_STAGE(PG8_SA(1, 0), a3, voffA);
            PG8_WAIT_V(8); PG8_WAIT_L(0); PG8_BAR; PG8_MMA(1, 0, At, B0); PG8_MMA(1, 1, At, B1); PG8_BAR; PG8_SCHED;
        }
        if constexpr (ALIGN_EPI) { if (wr == 0) PG8_BAR; }
        E(acc, cur, wr, wc, fr, fq);
        if (!has_next) break;
#pragma unroll
        for (int a = 0; a < 2; ++a)
#pragma unroll
            for (int b = 0; b < 2; ++b)
#pragma unroll
                for (int m = 0; m < 4; ++m)
#pragma unroll
                    for (int n = 0; n < 2; ++n) acc[a][b][m][n] = (f32x4){0.f, 0.f, 0.f, 0.f};
        cur = nxt; cA = nA; cB = nB; ++ui;
        if constexpr (ALIGN_EPI) { if (wr == 1) PG8_BAR; }
    }
    PG8_WAIT_V(0);
    if constexpr (!ALIGN_EPI) { if (wr == 0) PG8_BAR; }
    PG8_BAR;
#undef PG8_SA
#undef PG8_SB
#undef PG8_STAGE
#undef PG8_LDA
#undef PG8_LDB
#undef PG8_MMA
#undef PG8_WAIT_V
#undef PG8_WAIT_L
#undef PG8_BAR
#undef PG8_SCHED
}
}

struct Params {
    const float* x; const float* c; const float* w_ada; const float* b_ada; const float* w_in; const float* qg; const float* kvg;
    const float* w_uq; const float* w_uk; const float* w_uv; const float* w_out; const float* ln_g; const float* ln_b;
    float* out; unsigned char* ws; int layer; int pad;
};

constexpr int NWAVES = 8, NTHREADS = 512;
constexpr int LDS_BYTES = 152 * 1024;
struct Ctx { LAS unsigned char* lds; int tid, lane, wave, gw, ngw, bx, G; };
__device__ __forceinline__ Params fresh_params(const Params& p) { Params q = p; size_t z = 0; asm volatile("" : "+s"(z)); q.ws = p.ws + z; q.out = p.out + z; return q; }
__device__ __forceinline__ Ctx fresh_ctx(LAS unsigned char* lds, int wave_s) {
    Ctx C; C.lds = lds; asm volatile("" : "+s"(wave_s)); int ln; asm volatile("v_mbcnt_lo_u32_b32 %0, -1, 0\n\tv_mbcnt_hi_u32_b32 %0, -1, %0" : "=v"(ln));
    const int t = wave_s * 64 + ln; C.tid = t; C.lane = ln; C.wave = wave_s;
    int bx = blockIdx.x, G = gridDim.x; asm volatile("" : "+s"(bx)); asm volatile("" : "+s"(G)); C.bx = bx; C.G = G;
    C.gw = bx * NWAVES + C.wave; C.ngw = G * NWAVES; return C; }

__device__ __forceinline__ int map_in(int n, float& sc) {
    sc = 1.f;
    if (n < 1024) return n;
    if (n < 2304) { const int j = n - 1024;
        if (j < 384) { sc = QSC64; return 1056 + j; }
        if (j < 768) return 1440 + (j - 384);
        if (j < 1152) return 1824 + (j - 768);
        if (j < 1184) { const int w = j - 1152; return 1024 + (w >> 1) + 16 * (w & 1); }
        if (j < 1248) return 3488 + (j - 1184);
        if (j < 1256) return 3552 + (j - 1248);
        return -1; }
    if (n < 3072) { const int j = n - 2304; if (j < 256) sc = QSC64; return 2208 + j; }
    if (n < 3584) return 2976 + (n - 3072);
    return 3560 + (n - 3584);
}
constexpr int PT_IN = 72 * 16, PT_UQ = 12 * 12, PT_UKV = 12 * 4, PT_OUT = 16 * 16, PT_L = PT_IN + PT_UQ + PT_UKV + PT_OUT, PREP_TILES = 2 * PT_L;
__device__ __forceinline__ void prep_tile(const Params& p, int tile, LAS float* tl  , int tid) {
    const int l = tile / PT_L; int r = tile % PT_L;
    int kind, K;
    if (r < PT_IN) { kind = 0; K = 1024; } else if ((r -= PT_IN) < PT_UQ) { kind = 1; K = 768; } else if ((r -= PT_UQ) < PT_UKV) { kind = 2; K = 256; } else { r -= PT_UKV; kind = 3; K = 1024; }
    const int nkb = K / 64, n0 = (r / nkb) * 64, k0 = (r % nkb) * 64;
    const int i = tid & 63, j = tid >> 6, n = n0 + i;
    const float* src = nullptr; int srcN = 0, scol = -1; float cs = 1.f; const float* ks = nullptr; bf16_t* dst = nullptr;
    if (kind == 0) { src = p.w_in + (size_t)l * 1024 * INW; srcN = INW; scol = map_in(n, cs); dst = (bf16_t*)(p.ws + WS_WIN) + (size_t)l * NIN * 1024; }
    else if (kind == 1) { src = p.w_uq + (size_t)l * 768 * 576; srcN = 576; ks = p.qg + l * 768; cs = QSC96; dst = (bf16_t*)(p.ws + WS_WUQ) + (size_t)l * 768 * 768;
        if (n < 576) { const int h = n / 96, w = n % 96; scol = (w < 64) ? 96 * h + w : 96 * h + 64 + ((w - 64) >> 1) + 16 * ((w - 64) & 1); } }
    else if (kind == 2) { ks = p.kvg + l * 256; dst = (bf16_t*)(p.ws + WS_WUKV) + (size_t)l * 768 * 256; srcN = 384;
        if (n < 384) { src = p.w_uk + (size_t)l * 256 * 384; scol = n; } else { src = p.w_uv + (size_t)l * 256 * 384; scol = n - 384; } }
    else { src = p.w_out + (size_t)l * 1024 * 1024; srcN = 1024; scol = n; dst = (bf16_t*)(p.ws + WS_WOUT) + (size_t)l * 1024 * 1024; }
#pragma unroll
    for (int kk = j; kk < 64; kk += 8) { const int k = k0 + kk; float v = 0.f; if (scol >= 0) { v = src[(size_t)k * srcN + scol] * cs; if (ks) v *= ks[k]; } tl[kk * 65 + i] = v; }
    __syncthreads();
    { const int nn = tid >> 3, kc = tid & 7; u32x4 o;
      o.x = pk2(tl[(kc * 8 + 0) * 65 + nn], tl[(kc * 8 + 1) * 65 + nn]); o.y = pk2(tl[(kc * 8 + 2) * 65 + nn], tl[(kc * 8 + 3) * 65 + nn]);
      o.z = pk2(tl[(kc * 8 + 4) * 65 + nn], tl[(kc * 8 + 5) * 65 + nn]); o.w = pk2(tl[(kc * 8 + 6) * 65 + nn], tl[(kc * 8 + 7) * 65 + nn]);
      *(u32x4*)(dst + (size_t)(n0 + nn) * K + k0 + kc * 8) = o; }
    __syncthreads();
}
constexpr int MOD_ITEMS = 2 * 48;
__device__ __forceinline__ void mod_item(const Params& p, int item, LAS float* sc  , LAS float* part  , int tid) {
    const int l = item / 48, j0 = (item % 48) * 64, col = tid & 63, kg = tid >> 6;
    float acc[NB];
#pragma unroll
    for (int b = 0; b < NB; ++b) acc[b] = 0.f;
    const float* w = p.w_ada + (size_t)l * 1024 * 3072 + j0 + col;
    for (int k = kg * 128; k < kg * 128 + 128; ++k) { const float wv = w[(size_t)k * 3072];
#pragma unroll
        for (int b = 0; b < NB; ++b) acc[b] += sc[b * 1024 + k] * wv; }
#pragma unroll
    for (int b = 0; b < NB; ++b) part[(kg * 8 + b) * 64 + col] = acc[b];
    __syncthreads();
    { const int b = tid >> 6; float s = p.b_ada[l * 3072 + j0 + col];
#pragma unroll
      for (int g = 0; g < 8; ++g) s += part[(g * 8 + b) * 64 + col];
      ((float*)(p.ws + WS_MOD))[((size_t)l * NB + b) * 3072 + j0 + col] = s; }
    __syncthreads();
}
__device__ __forceinline__ void rope_entry(int pos, int i, float& c, float& s) {
    const float th = exp2f(-(float)i * (13.287712379549449f / 16.0f));
    const float angf = (float)pos * th;
    const double a = (double)angf, n = rint(a * 0.15915494309189535), r = (a - n * 6.283185307179586) - n * 2.4492935982947064e-16;
    const double r2 = r * r; double sn = 0.0, cs = 0.0, ts = r, tc = 1.0;
#pragma unroll
    for (int k = 0; k < 14; ++k) { sn += ts; cs += tc; tc = -tc * r2 / (double)((2 * k + 1) * (2 * k + 2)); ts = -ts * r2 / (double)((2 * k + 2) * (2 * k + 3)); }
    c = (float)cs; s = (float)sn;
}
__device__ __forceinline__ void phase_prologue(const Params& p, const Ctx& C) {
    LAS float* tl = (LAS float*)C.lds;
    for (int t = C.bx; t < PREP_TILES; t += C.G) prep_tile(p, t, tl, C.tid);
    if (C.bx < MOD_ITEMS) {
        LAS float* sc = (LAS float*)C.lds; LAS float* part = sc + NB * 1024;
        for (int e = C.tid; e < NB * 1024; e += NTHREADS) sc[e] = silu(p.c[e]);
        __syncthreads();
        mod_item(p, C.bx, sc, part, C.tid);
    }
    float* tab = (float*)(p.ws + WS_ROPE);
    for (int e = C.bx * NTHREADS + C.tid; e < SEQ * 16; e += C.G * NTHREADS) { float c, s; rope_entry(e >> 4, e & 15, c, s); tab[2 * e] = c; tab[2 * e + 1] = s; }
}
__device__ __forceinline__ void phase_makeh(const Params& p, const Ctx& C) {
    for (size_t e = ((size_t)C.bx * NTHREADS + C.tid) * 8; e < (size_t)T * DM; e += (size_t)C.G * NTHREADS * 8) {
        const int m = (int)(e >> 10), k = (int)(e & 1023), b = m / SEQ;
        const float* mod = (const float*)(p.ws + WS_MOD) + (size_t)b * 3072;
        const f32x4 x0 = *(const f32x4*)(p.x + e), x1 = *(const f32x4*)(p.x + e + 4);
        const f32x4 sh0 = *(const f32x4*)(mod + k), sh1 = *(const f32x4*)(mod + k + 4), s0 = *(const f32x4*)(mod + 1024 + k), s1 = *(const f32x4*)(mod + 1024 + k + 4);
        const f32x4 h0 = x0 * (s0 + 1.0f) + sh0, h1 = x1 * (s1 + 1.0f) + sh1;
        u32x4 o; o.x = pk2(h0.x, h0.y); o.y = pk2(h0.z, h0.w); o.z = pk2(h1.x, h1.y); o.w = pk2(h1.z, h1.w);
        *(u32x4*)((bf16_t*)(p.ws + WS_H) + e) = o;
    }
}
__device__ __forceinline__ u32x4 pack8(f32x4 v0, f32x4 v1) { u32x4 w; w.x = pk2(v0[0], v0[1]); w.y = pk2(v0[2], v0[3]); w.z = pk2(v1[0], v1[1]); w.w = pk2(v1[2], v1[3]); return w; }
__device__ __forceinline__ float ssq8(const u32x4 w) { float f[8]; unpack8(w, f); return ((f[0] * f[0] + f[1] * f[1]) + (f[2] * f[2] + f[3] * f[3])) + ((f[4] * f[4] + f[5] * f[5]) + (f[6] * f[6] + f[7] * f[7])); }
struct EpiIn {
    static constexpr bool PERM = true;
    unsigned char* ws;
    __device__ __forceinline__ void operator()(const f32x4 (&acc)[2][2][4][2], const pg8::Unit& u, int wr, int wc, int fr, int fq) const {
        using namespace pg8;
        const int pn = u.pn, row0 = u.pm * BM + wr * 64 + fr, colt = wc * 32 + 8 * fq; unsigned base, ld, c0;
        if (pn < 4) { base = (unsigned)WS_PA; ld = LD_PA; c0 = pn * 256; }
        else if (pn < 9) { base = (unsigned)WS_PB; ld = LD_PB; c0 = (pn - 4) * 256; }
        else if (pn < 12) { base = (unsigned)WS_PC; ld = LD_PC; c0 = (pn - 9) * 256; }
        else if (pn < 14) { base = (unsigned)WS_PI; ld = LD_PI; c0 = (pn - 12) * 256; }
        else { base = (unsigned)WS_PG; ld = LD_PG; c0 = (pn - 14) * 256; }
        const bool t8 = (pn == 8);
#pragma unroll
        for (int ai = 0; ai < 2; ++ai)
#pragma unroll
            for (int m = 0; m < 4; ++m) { const int row = row0 + ai * HALF + m * 16; float ssq = 0.f;
#pragma unroll
                for (int bj = 0; bj < 2; ++bj) { f32x4 v0 = acc[ai][bj][m][0], v1 = acc[ai][bj][m][1];
                    if (bj == 1 && t8) {
                        if (wc == 0) {
                            const unsigned pos = (unsigned)row % SEQ, to = (unsigned)WS_ROPE + (pos * 16u + 4u * fq) * 8u;
                            const f32x4 t0 = *(const f32x4*)(ws + to), t1 = *(const f32x4*)(ws + to + 16u);
                            f32x4 a, b;
                            a[0] = v0[0] * t0[0] - v0[1] * t0[1]; a[1] = v0[0] * t0[1] + v0[1] * t0[0];
                            a[2] = v0[2] * t0[2] - v0[3] * t0[3]; a[3] = v0[2] * t0[3] + v0[3] * t0[2];
                            b[0] = v1[0] * t1[0] - v1[1] * t1[1]; b[1] = v1[0] * t1[1] + v1[1] * t1[0];
                            b[2] = v1[2] * t1[2] - v1[3] * t1[3]; b[3] = v1[2] * t1[3] + v1[3] * t1[2];
                            const u32x4 w = pack8(a, b); const unsigned ko = (unsigned)WS_KA + ((unsigned)row * LD_KA + 64u + 8u * fq) * 2u;
#pragma unroll
                            for (int h = 0; h < 6; ++h) *(u32x4*)(ws + ko + h * 192u) = w;
                        } else if (wc < 3) {
                            const unsigned d8 = (unsigned)(wc - 1) * 4u + fq;
                            *(u32x4*)(ws + ((unsigned)WS_KI2 + ((unsigned)row >> 5) * 4096u + (d8 >> 1) * 1024u + (d8 & 1u) * 512u + ((unsigned)row & 31u) * 16u)) = pack8(v0, v1);
                        } else if (fq == 0) {
                            *(u32x4*)(ws + ((unsigned)WS_PB + ((unsigned)row * LD_PB + PB_WI) * 2u)) = pack8(v0, v1);
                        }
                    } else {
                        const u32x4 w = pack8(v0, v1);
                        *(u32x4*)(ws + (base + ((unsigned)row * ld + c0 + colt + bj * HALF) * 2u)) = w;
                        if (pn < 4) ssq += ssq8(w);
                    } }
                if (pn < 4) { ssq += __shfl_xor(ssq, 16); ssq += __shfl_xor(ssq, 32);
                    if (fq == 0) *(float*)(ws + ((unsigned)WS_SSQ + ((unsigned)row * 16u + pn * 4u + wc) * 4u)) = ssq; }
                asm volatile("" ::: "memory"); }
    }
};
struct FUq { unsigned char* ws;
    __device__ __forceinline__ float row(int row) const {
        const f32x4* q = (const f32x4*)(ws + ((unsigned)WS_SSQ + (unsigned)row * 64u)); const f32x4 a = q[0], b = q[1], c = q[2];
        return rsqrtf((((a[0] + a[1]) + (a[2] + a[3])) + ((b[0] + b[1]) + (b[2] + b[3])) + ((c[0] + c[1]) + (c[2] + c[3]))) * (1.0f / 768.0f) + 1e-6f);
    }
    __device__ __forceinline__ void operator()(int row, int col, f32x4 v0, f32x4 v1, float r) const {
        if (col >= 576) return;
        v0 = v0 * r; v1 = v1 * r;
        const int w = col % 96;
        if (w >= 64) { const unsigned i0 = (unsigned)(w - 64) >> 1, pos = (unsigned)row % SEQ; const unsigned to = (unsigned)WS_ROPE + (pos * 16u + i0) * 8u;
            const f32x4 t0 = *(const f32x4*)(ws + to), t1 = *(const f32x4*)(ws + to + 16u);
            f32x4 a, b;
            a[0] = v0[0] * t0[0] - v0[1] * t0[1]; a[1] = v0[0] * t0[1] + v0[1] * t0[0];
            a[2] = v0[2] * t0[2] - v0[3] * t0[3]; a[3] = v0[2] * t0[3] + v0[3] * t0[2];
            b[0] = v1[0] * t1[0] - v1[1] * t1[1]; b[1] = v1[0] * t1[1] + v1[1] * t1[0];
            b[2] = v1[2] * t1[2] - v1[3] * t1[3]; b[3] = v1[2] * t1[3] + v1[3] * t1[2];
            v0 = a; v1 = b; }
        *(u32x4*)(ws + ((unsigned)WS_QA + ((unsigned)row * LD_QA + (unsigned)col) * 2u)) = pack8(v0, v1);
    }
};
struct FUkv { unsigned char* ws;
    __device__ __forceinline__ float row(int row) const {
        const f32x4 a = *(const f32x4*)(ws + ((unsigned)WS_SSQ + (unsigned)row * 64u + 48u));
        return rsqrtf(((a[0] + a[1]) + (a[2] + a[3])) * (1.0f / 256.0f) + 1e-6f);
    }
    __device__ __forceinline__ void operator()(int row, int col, f32x4 v0, f32x4 v1, float r) const {
        v0 = v0 * r; v1 = v1 * r;
        const unsigned off = (col < 384) ? (unsigned)WS_KA + ((unsigned)row * LD_KA + (unsigned)((col >> 6) * 96 + (col & 63))) * 2u
                                         : (unsigned)WS_VA + ((unsigned)row * LD_VA + (unsigned)(col - 384)) * 2u;
        *(u32x4*)(ws + off) = pack8(v0, v1);
    }
};
struct FOut { const float* xin; float* out; const float* mod;
    __device__ __forceinline__ float row(int) const { return 0.f; }
    __device__ __forceinline__ void operator()(int row, int col, f32x4 v0, f32x4 v1, float) const {
        const unsigned b = (unsigned)row / SEQ; const unsigned go = (b * 3072u + 2048u + (unsigned)col) * 4u;
        const f32x4 g0 = *(const f32x4*)((const char*)mod + go), g1 = *(const f32x4*)((const char*)mod + go + 16u);
        const unsigned off = ((unsigned)row * DM + (unsigned)col) * 4u;
        const f32x4 x0 = *(const f32x4*)((const char*)xin + off), x1 = *(const f32x4*)((const char*)xin + off + 16u);
        *(f32x4*)((char*)out + off) = x0 * ALPHA + (g0 + 1.0f) * v0; *(f32x4*)((char*)out + off + 16u) = x1 * ALPHA + (g1 + 1.0f) * v1;
    }
};
template <int WHICH> __device__ __forceinline__ void phase_gemm(const Params& p, const Ctx& C, int l) {
    pg8::StaticOrder S;
    if constexpr (WHICH == 0) {
        pg8::Gemm g{(const bf16_t*)(p.ws + WS_H), (const bf16_t*)(p.ws + WS_WIN) + (size_t)l * NIN * 1024, T, NIN, 1024, 1024, 1024};
        S.init(T, NIN, C.G, C.bx); EpiIn E{p.ws};
        pg8::gemm_phase<EpiIn, pg8::StaticOrder, true>(C.lds, g, S, E, C.tid);
    } else if constexpr (WHICH == 1) {
        pg8::Gemm g{(const bf16_t*)(p.ws + WS_PA), (const bf16_t*)(p.ws + WS_WUQ) + (size_t)l * 768 * 768, T, 768, 768, LD_PA, 768};
        S.init(T, 768, C.G, C.bx); pg8::EpiChunk<FUq> E{FUq{p.ws}};
        pg8::gemm_phase<pg8::EpiChunk<FUq>, pg8::StaticOrder, true>(C.lds, g, S, E, C.tid);
    } else if constexpr (WHICH == 2) {
        pg8::Gemm g{(const bf16_t*)(p.ws + WS_PA) + 768, (const bf16_t*)(p.ws + WS_WUKV) + (size_t)l * 768 * 256, T, 768, 256, LD_PA, 256};
        S.init(T, 768, C.G, C.bx); pg8::EpiChunk<FUkv> E{FUkv{p.ws}};
        pg8::gemm_phase<pg8::EpiChunk<FUkv>, pg8::StaticOrder, true>(C.lds, g, S, E, C.tid);
    } else {
        pg8::Gemm g{(const bf16_t*)(p.ws + WS_Y), (const bf16_t*)(p.ws + WS_WOUT) + (size_t)l * 1024 * 1024, T, 1024, 1024, 1024, 1024};
        S.init(T, 1024, C.G, C.bx);
        pg8::EpiChunk<FOut> E{FOut{l == 0 ? p.x : p.out, p.out, (const float*)(p.ws + WS_MOD) + (size_t)l * NB * 3072}};
        pg8::gemm_phase<pg8::EpiChunk<FOut>, pg8::StaticOrder, true>(C.lds, g, S, E, C.tid);
    }
}
__device__ __forceinline__ void phase_ln(const Params& p, const Ctx& C, int l) {
    const int lane = C.lane;
    for (int m = C.gw; m < T; m += C.ngw) {
        float* row = p.out + (size_t)m * DM;
        f32x4 v[4]; float s = 0.f;
#pragma unroll
        for (int j = 0; j < 4; ++j) { v[j] = *(const f32x4*)(row + j * 256 + lane * 4); s += (v[j].x + v[j].y) + (v[j].z + v[j].w); }
        const float mean = wave_sum(s) * (1.0f / DM); float s2 = 0.f;
#pragma unroll
        for (int j = 0; j < 4; ++j) { v[j] = v[j] - mean; s2 += (v[j].x * v[j].x + v[j].y * v[j].y) + (v[j].z * v[j].z + v[j].w * v[j].w); }
        const float rstd = rsqrtf(wave_sum(s2) * (1.0f / DM) + 1e-5f);
        const float* g = p.ln_g + l * DM; const float* bb = p.ln_b + l * DM;
        const int b = m / SEQ; const float* mod = (const float*)(p.ws + WS_MOD) + ((size_t)(l + 1) * NB + b) * 3072;
#pragma unroll
        for (int j = 0; j < 4; ++j) { const int k = j * 256 + lane * 4;
            const f32x4 y = v[j] * rstd * *(const f32x4*)(g + k) + *(const f32x4*)(bb + k);
            *(f32x4*)(row + k) = y;
            if (l + 1 < DEPTH) { const f32x4 h = y * (*(const f32x4*)(mod + 1024 + k) + 1.0f) + *(const f32x4*)(mod + k);
                unsigned long long o = (unsigned long long)pk2(h.x, h.y) | ((unsigned long long)pk2(h.z, h.w) << 32);
                *(unsigned long long*)((bf16_t*)(p.ws + WS_H) + (size_t)m * DM + k) = o; } }
    }
}

__device__ __forceinline__ float rdlane(float v, int l) { return __uint_as_float(__builtin_amdgcn_readlane(__float_as_uint(v), l)); }
__device__ __forceinline__ unsigned fkey(float f) { unsigned u = __float_as_uint(f); if (u == 0x80000000u) u = 0u; return (u & 0x80000000u) ? ~u : (u | 0x80000000u); }

namespace fa {
typedef float f32x16 __attribute__((ext_vector_type(16)));
typedef short s16x4 __attribute__((ext_vector_type(4)));
typedef short v4i16_t __attribute__((ext_vector_type(4)));
typedef float f32x2_t __attribute__((ext_vector_type(2)));
typedef __bf16 bf16x2_t __attribute__((ext_vector_type(2)));
constexpr float THR = 8.0f;
constexpr float MINIT = -1.0e30f;
constexpr int KSLOT = 12288, VSLOT = 8192;
constexpr int L_K = 0, L_V = 2 * KSLOT, L_WS = L_V + 2 * VSLOT, L_OST = L_WS + NWAVES * 256, L_END = L_OST + NWAVES * 4096;
__device__ __forceinline__ int crow(int r, int hi) { return (r & 3) + 8 * (r >> 2) + 4 * hi; }
__device__ __forceinline__ unsigned cvtpk(float lo, float hi) { f32x2_t v = {lo, hi}; bf16x2_t b = __builtin_convertvector(v, bf16x2_t); return __builtin_bit_cast(unsigned, b); }
__device__ __forceinline__ float max32(float v) { auto rr = __builtin_amdgcn_permlane32_swap(__float_as_uint(v), __float_as_uint(v), false, false); return fmaxf(__uint_as_float(rr[0]), __uint_as_float(rr[1])); }
__device__ __forceinline__ float sum32(float v) { auto rr = __builtin_amdgcn_permlane32_swap(__float_as_uint(v), __float_as_uint(v), false, false); return __uint_as_float(rr[0]) + __uint_as_float(rr[1]); }
#define FA_WAIT_BAR() asm volatile("s_waitcnt vmcnt(0) lgkmcnt(0)\n\ts_barrier" ::: "memory")
#define FA_LDS_WAIT() asm volatile("s_waitcnt lgkmcnt(0)" ::: "memory")
__device__ __forceinline__ void glds16(const void* gsrc, LAS unsigned char* dst_uniform) { __builtin_amdgcn_global_load_lds((const unsigned*)gsrc, (LAS unsigned*)dst_uniform, 16, 0, 0); }
template <int NCH> __device__ __forceinline__ void dma_k(const bf16_t* kptr, LAS unsigned char* kslot, int wid) {
#pragma unroll
    for (int c0 = 0; c0 < NCH; c0 += 8) { const int c = c0 + wid; if (c < NCH) glds16(kptr + c * 8, kslot + c * 1024); }
}
__device__ __forceinline__ void dma_v(const bf16_t* vptr, LAS unsigned char* vslot, int wid) { glds16(vptr, vslot + wid * 1024); }
template <int NKS> __device__ __forceinline__ void qkt(f32x16& p0, f32x16& p1, const LAS unsigned char* kslot, const bf16x8* qr, int r32, int hi) {
    const LAS unsigned char* kb = kslot + hi * 1024 + r32 * 16;
#pragma unroll
    for (int d0 = 0; d0 < NKS; ++d0) {
        const bf16x8 b0 = *(const LAS bf16x8*)(kb + d0 * 2048), b1 = *(const LAS bf16x8*)(kb + d0 * 2048 + 512);
        p0 = __builtin_amdgcn_mfma_f32_32x32x16_bf16(b0, qr[d0], p0, 0, 0, 0);
        p1 = __builtin_amdgcn_mfma_f32_32x32x16_bf16(b1, qr[d0], p1, 0, 0, 0);
    }
}
__device__ __forceinline__ s16x4 vtr(const LAS unsigned char* p) { return __builtin_bit_cast(s16x4, __builtin_amdgcn_ds_read_tr16_b64_v4i16((LAS v4i16_t*)p)); }
struct State { float m, l; f32x16 o[2]; };
__device__ __forceinline__ void init_state(State& s) { s.m = MINIT; s.l = 0.f;
#pragma unroll
    for (int r = 0; r < 16; ++r) { s.o[0][r] = 0.f; s.o[1][r] = 0.f; } }
__device__ __forceinline__ void softmax_pv(State& s, f32x16& p0, f32x16& p1, const LAS unsigned char* vslot, LAS float* wsf, int lane, int r32, int hi) {
    float rm = fmaxf(p0[0], p1[0]);
#pragma unroll
    for (int r = 1; r < 16; ++r) rm = fmaxf(rm, fmaxf(p0[r], p1[r]));
    rm = max32(rm);
    if (__any(rm > s.m + THR)) {
        const float mn = fmaxf(s.m, rm), f = __builtin_amdgcn_exp2f(s.m - mn);
        s.l *= f; s.m = mn;
        FA_LDS_WAIT();
        if (hi == 0) wsf[r32] = f;
        FA_LDS_WAIT();
#pragma unroll
        for (int r = 0; r < 16; ++r) { const float fr = wsf[crow(r, hi)]; s.o[0][r] *= fr; s.o[1][r] *= fr; }
    }
    float sum = 0.f;
#pragma unroll
    for (int r = 0; r < 16; ++r) { p0[r] = __builtin_amdgcn_exp2f(p0[r] - s.m); p1[r] = __builtin_amdgcn_exp2f(p1[r] - s.m); sum += p0[r] + p1[r]; }
    s.l += sum;
    u32x4 pw[4];
#pragma unroll
    for (int k = 0; k < 2; ++k) {
        pw[k]     = (u32x4){cvtpk(p0[8 * k], p0[8 * k + 1]), cvtpk(p0[8 * k + 2], p0[8 * k + 3]), cvtpk(p0[8 * k + 4], p0[8 * k + 5]), cvtpk(p0[8 * k + 6], p0[8 * k + 7])};
        pw[2 + k] = (u32x4){cvtpk(p1[8 * k], p1[8 * k + 1]), cvtpk(p1[8 * k + 2], p1[8 * k + 3]), cvtpk(p1[8 * k + 4], p1[8 * k + 5]), cvtpk(p1[8 * k + 6], p1[8 * k + 7])};
    }
    const LAS unsigned char* vb = vslot + ((lane >> 4) & 1) * 32 + (lane & 3) * 8 + (4 * hi + ((lane & 15) >> 2)) * 64;
#pragma unroll
    for (int dh = 0; dh < 2; ++dh)
#pragma unroll
        for (int ks = 0; ks < 4; ++ks) {
            const s16x4 lo = vtr(vb + dh * 4096 + ks * 1024), hh = vtr(vb + dh * 4096 + ks * 1024 + 512);
            const bf16x8 vf = (bf16x8){lo[0], lo[1], lo[2], lo[3], hh[0], hh[1], hh[2], hh[3]};
            s.o[dh] = __builtin_amdgcn_mfma_f32_32x32x16_bf16(__builtin_bit_cast(bf16x8, pw[ks]), vf, s.o[dh], 0, 0, 0);
        }
}
__device__ __forceinline__ void finish(State& s, LAS float* wsf, LAS bf16_t* stg, int r32, int hi, float* lse2) {
    const float lt = sum32(s.l);
    *lse2 = s.m + __builtin_amdgcn_logf(lt);
    FA_LDS_WAIT();
    if (hi == 0) wsf[32 + r32] = __builtin_amdgcn_rcpf(lt);
    FA_LDS_WAIT();
#pragma unroll
    for (int r = 0; r < 16; ++r) { const int orow = crow(r, hi); const float inv = wsf[32 + orow];
        stg[orow * 64 + r32] = (bf16_t)f2bf(s.o[0][r] * inv); stg[orow * 64 + 32 + r32] = (bf16_t)f2bf(s.o[1][r] * inv); }
    FA_LDS_WAIT();
}
}

__device__ __forceinline__ void mla_unit(const Params& p, LAS unsigned char* lds, int b, int h, int qb, int tid) {
    using namespace fa;
    const int lane = tid & 63, r32 = lane & 31, hi = lane >> 5, wid = __builtin_amdgcn_readfirstlane(tid >> 6);
    const int q0 = qb * 256; const size_t rowbase = (size_t)b * SEQ;
    const bf16_t* QA = (const bf16_t*)(p.ws + WS_QA); const bf16_t* KA = (const bf16_t*)(p.ws + WS_KA); const bf16_t* VA = (const bf16_t*)(p.ws + WS_VA);
    LAS float* wsf = (LAS float*)(lds + L_WS) + wid * 64; LAS bf16_t* stg = (LAS bf16_t*)(lds + L_OST) + wid * 2048;
    const bf16_t* kptr = KA + (rowbase + lane) * LD_KA + h * 96;
    const bf16_t* vptr = VA + (rowbase + 16 * (wid & 3) + (lane >> 2)) * LD_VA + h * 64 + (wid >> 2) * 32 + (lane & 3) * 8;
    const int NT = (q0 + 256) / 64;
    FA_WAIT_BAR();
    dma_k<12>(kptr, lds + L_K, wid); dma_v(vptr, lds + L_V, wid);
    bf16x8 qr[6];
    { const bf16_t* qw = QA + (rowbase + q0 + wid * 32 + r32) * LD_QA + h * 96 + hi * 8;
#pragma unroll
      for (int d0 = 0; d0 < 6; ++d0) qr[d0] = *(const bf16x8*)(qw + d0 * 16); }
    State st; init_state(st);
    const int qmin = q0 + wid * 32, q = qmin + r32;
    for (int t = 0; t < NT; ++t) {
        FA_WAIT_BAR();
        const int sl = t & 1;
        if (t + 1 < NT) { dma_k<12>(kptr + (size_t)(t + 1) * 64 * LD_KA, lds + L_K + (sl ^ 1) * KSLOT, wid); dma_v(vptr + (size_t)(t + 1) * 64 * LD_VA, lds + L_V + (sl ^ 1) * VSLOT, wid); }
        if (64 * t <= qmin + 31) {
            f32x16 p0, p1;
#pragma unroll
            for (int r = 0; r < 16; ++r) { p0[r] = 0.f; p1[r] = 0.f; }
            qkt<6>(p0, p1, lds + L_K + sl * KSLOT, qr, r32, hi);
            if (64 * t + 63 > qmin) {
#pragma unroll
                for (int r = 0; r < 16; ++r) { const int kv = 64 * t + crow(r, hi); if (kv > q) p0[r] = -INFINITY; if (kv + 32 > q) p1[r] = -INFINITY; }
            }
            softmax_pv(st, p0, p1, lds + L_V + sl * VSLOT, wsf, lane, r32, hi);
        }
    }
    float lse2; finish(st, wsf, stg, r32, hi, &lse2);
    const bf16_t* PG = (const bf16_t*)(p.ws + WS_PG); bf16_t* Y = (bf16_t*)(p.ws + WS_Y);
#pragma unroll
    for (int i = 0; i < 4; ++i) { const int row = i * 8 + (lane >> 3), ch = lane & 7; const size_t m = rowbase + q0 + wid * 32 + row;
        float o8[8], g8[8]; unpack8(*(const LAS u32x4*)(stg + row * 64 + ch * 8), o8); unpack8(*(const u32x4*)(PG + m * LD_PG + h * 64 + ch * 8), g8);
        u32x4 w; w.x = pk2(o8[0] * silu(g8[0]), o8[1] * silu(g8[1])); w.y = pk2(o8[2] * silu(g8[2]), o8[3] * silu(g8[3]));
        w.z = pk2(o8[4] * silu(g8[4]), o8[5] * silu(g8[5])); w.w = pk2(o8[6] * silu(g8[6]), o8[7] * silu(g8[7]));
        *(u32x4*)(Y + m * DM + h * 64 + ch * 8) = w; }
}
__device__ __forceinline__ void phase_mla(const Params& p, const Ctx& C) {
    const int G = C.G, bx = C.bx, vcu = (G % 8 == 0) ? (bx % 8) * (G / 8) + bx / 8 : bx;
    for (int v = vcu; v < 256; v += G) {
        const int g = v >> 4, i = v & 15;
#pragma unroll 1
        for (int j = 0; j < 3; ++j) {
            const int bh = 3 * g + j, qb = (j == 0) ? i : (j == 1) ? ((i + 8) & 15) : (i < 8 ? 15 - 2 * i : 30 - 2 * i);
            mla_unit(p, C.lds, bh / 6, bh % 6, qb, C.tid);
        }
    }
    __syncthreads();
}

__device__ __forceinline__ void sparse_unit(const Params& p, LAS unsigned char* lds, int b, int h, int qb, int tid) {
    using namespace fa;
    const int lane = tid & 63, r32 = lane & 31, hi = lane >> 5, wid = __builtin_amdgcn_readfirstlane(tid >> 6);
    const int q0 = qb * 256; const size_t rowbase = (size_t)b * SEQ;
    const bf16_t* PC = (const bf16_t*)(p.ws + WS_PC);
    LAS float* wsf = (LAS float*)(lds + L_WS) + wid * 64; LAS bf16_t* stg = (LAS bf16_t*)(lds + L_OST) + wid * 2048;
    const bf16_t* kptr = PC + (rowbase + lane) * LD_PC + 256 + h * 64;
    const bf16_t* vptr = PC + (rowbase + 16 * (wid & 3) + (lane >> 2)) * LD_PC + 512 + h * 64 + (wid >> 2) * 32 + (lane & 3) * 8;
    const int NT = (q0 + 256) / 64;
    FA_WAIT_BAR();
    dma_k<8>(kptr, lds + L_K, wid); dma_v(vptr, lds + L_V, wid);
    const int qmin = q0 + wid * 32, q = qmin + r32;
    bf16x8 qr[4];
    { const bf16_t* qw = PC + (rowbase + q) * LD_PC + h * 64 + hi * 8;
#pragma unroll
      for (int d0 = 0; d0 < 4; ++d0) qr[d0] = *(const bf16x8*)(qw + d0 * 16); }
    const u64* mrow = (const u64*)(p.ws + WS_MASK) + (rowbase + q) * 64;
    const float sl2 = exp2f(-0.8f * (float)(7 + h)) * LOG2E;
    State st; init_state(st);
    const int nact = (qmin + 31) / 64 + 1;
    u64 wcur = mrow[0];
    for (int t = 0; t < NT; ++t) {
        FA_WAIT_BAR();
        const int sl = t & 1;
        if (t + 1 < NT) { dma_k<8>(kptr + (size_t)(t + 1) * 64 * LD_PC, lds + L_K + (sl ^ 1) * KSLOT, wid); dma_v(vptr + (size_t)(t + 1) * 64 * LD_PC, lds + L_V + (sl ^ 1) * VSLOT, wid); }
        if (t < nact) {
            const u64 wnext = (t + 1 < nact) ? mrow[t + 1] : 0ull;
            if (__any(wcur != 0ull)) {
                const unsigned wl = (unsigned)wcur >> (4 * hi), wh = (unsigned)(wcur >> 32) >> (4 * hi);
                const float base = sl2 * (float)(64 * t + 4 * hi - q);
                f32x16 p0, p1;
#pragma unroll
                for (int r = 0; r < 16; ++r) { const int cr = (r & 3) + 8 * (r >> 2);
                    p0[r] = (wl & (1u << cr)) ? fmaf(sl2, (float)cr, base) : -INFINITY;
                    p1[r] = (wh & (1u << cr)) ? fmaf(sl2, (float)(cr + 32), base) : -INFINITY; }
                qkt<4>(p0, p1, lds + L_K + sl * KSLOT, qr, r32, hi);
                softmax_pv(st, p0, p1, lds + L_V + sl * VSLOT, wsf, lane, r32, hi);
            }
            wcur = wnext;
        }
    }
    float lse2; finish(st, wsf, stg, r32, hi, &lse2);
    const bf16_t* PG = (const bf16_t*)(p.ws + WS_PG); bf16_t* Y = (bf16_t*)(p.ws + WS_Y);
#pragma unroll
    for (int i = 0; i < 4; ++i) { const int row = i * 8 + (lane >> 3), ch = lane & 7; const size_t m = rowbase + q0 + wid * 32 + row;
        float o8[8], g8[8]; unpack8(*(const LAS u32x4*)(stg + row * 64 + ch * 8), o8); unpack8(*(const u32x4*)(PG + m * LD_PG + 768 + h * 64 + ch * 8), g8);
        u32x4 w; w.x = pk2(o8[0] * silu(g8[0]), o8[1] * silu(g8[1])); w.y = pk2(o8[2] * silu(g8[2]), o8[3] * silu(g8[3]));
        w.z = pk2(o8[4] * silu(g8[4]), o8[5] * silu(g8[5])); w.w = pk2(o8[6] * silu(g8[6]), o8[7] * silu(g8[7]));
        *(u32x4*)(Y + m * DM + 768 + h * 64 + ch * 8) = w; }
}
__device__ __forceinline__ void phase_sparse(const Params& p, const Ctx& C) {
    const int G = C.G, bx = C.bx, vcu = (G % 8 == 0) ? (bx % 8) * (G / 8) + bx / 8 : bx;
    for (int v = vcu; v < 256; v += G) {
        const int bh = v >> 3, i = v & 7;
        sparse_unit(p, C.lds, bh >> 2, bh & 3, i, C.tid);
        sparse_unit(p, C.lds, bh >> 2, bh & 3, 15 - i, C.tid);
    }
    __syncthreads();
}

constexpr unsigned NEGKEY = 0x007FFFFFu;
constexpr int IX_SC = 0, IX_HIST = 131072, IX_CAND = IX_HIST + NWAVES * 2048, IX_END = IX_CAND + NWAVES * 512;
template <int R> __device__ __forceinline__ void put_word(unsigned& mlo, unsigned& mhi, u64 word) {
    const unsigned wl = (unsigned)word, wh = (unsigned)(word >> 32);
    asm("s_nop 3\n\tv_writelane_b32 %0, %2, %4\n\tv_writelane_b32 %1, %3, %4" : "+v"(mlo), "+v"(mhi) : "s"(wl), "s"(wh), "i"(R));
}
template <int R> struct OutWordsK {
    static __device__ __forceinline__ void run(const unsigned (&u)[64], unsigned thr, int need, int& run_, u64 ltmask, unsigned& mlo, unsigned& mhi) {
        const bool gt = u[R] > thr, eq = u[R] == thr; const u64 beq = __ballot(eq); const int pos = run_ + __popcll(beq & ltmask);
        const u64 word = __ballot(gt || (eq && pos < need)); run_ += __popcll(beq); put_word<R>(mlo, mhi, word);
        OutWordsK<R + 1>::run(u, thr, need, run_, ltmask, mlo, mhi);
    }
};
template <> struct OutWordsK<64> { static __device__ __forceinline__ void run(const unsigned (&)[64], unsigned, int, int&, u64, unsigned&, unsigned&) {} };
__device__ __forceinline__ u64 select256(const unsigned (&u)[64], int lane) {
    unsigned thr = 0u; int cge = 0;
    for (int bit = 31; bit >= 0; --bit) {
        const unsigned cand = thr | (1u << bit); int c = 0;
#pragma unroll
        for (int r = 0; r < 64; ++r) c += __popcll(__ballot(u[r] >= cand));
        if (c >= 256) { thr = cand; cge = c; if (c == 256) break; }
    }
    unsigned mlo = 0u, mhi = 0u;
    int cgt = 0;
#pragma unroll
    for (int r = 0; r < 64; ++r) cgt += __popcll(__ballot(u[r] > thr));
    const int need = 256 - cgt; int run = 0;
    const u64 ltmask = (lane == 0) ? 0ull : (~0ull >> (64 - lane));
    OutWordsK<0>::run(u, thr, need, run, ltmask, mlo, mhi);
    (void)cge;
    return (u64)mlo | ((u64)mhi << 32);
}
__device__ __forceinline__ int dpp_scan_incl(int v) {
    v += __builtin_amdgcn_update_dpp(0, v, 0x111, 0xf, 0xf, false);
    v += __builtin_amdgcn_update_dpp(0, v, 0x112, 0xf, 0xf, false);
    v += __builtin_amdgcn_update_dpp(0, v, 0x114, 0xf, 0xf, false);
    v += __builtin_amdgcn_update_dpp(0, v, 0x118, 0xf, 0xf, false);
    v += __builtin_amdgcn_update_dpp(0, v, 0x142, 0xa, 0xf, false);
    v += __builtin_amdgcn_update_dpp(0, v, 0x143, 0xc, 0xf, false);
    return v;
}
__device__ __forceinline__ unsigned cvt_u32(float x) { unsigned r; asm("v_cvt_u32_f32 %0, %1" : "=v"(r) : "v"(x)); return r; }
__device__ __forceinline__ float vmax_abs(float a, float b) { float r; asm("v_max_f32 %0, %1, |%2|" : "=v"(r) : "v"(a), "v"(b)); return r; }
template <int NR, bool TIE> struct OutWords2;
template <int NR> __device__ __forceinline__ bool select_row_fast(const LAS float* row, int lane, LAS unsigned* hist, LAS float* cs, LAS int* ci, u64& out) {
    float s[NR];
#pragma unroll
    for (int r = 0; r < NR; ++r) s[r] = row[64 * r + lane];
    float R = 0.f;
#pragma unroll
    for (int r = 0; r < NR; ++r) R = vmax_abs(R, s[r]);
    R = wave_max(R); R = fmaxf(R, 1e-30f);
    const float c4 = 2047.9f / (2.0f * R), o4 = R * c4;
#pragma unroll
    for (int i = 0; i < 8; ++i) hist[i * 64 + lane] = 0u;
#pragma unroll
    for (int r = 0; r < NR; ++r) { const unsigned a = cvt_u32(fmaf(s[r], c4, o4)) & 0x7fcu; __hip_atomic_fetch_add((LAS unsigned*)((LAS unsigned char*)hist + a), 1u, __ATOMIC_RELAXED, __HIP_MEMORY_SCOPE_WORKGROUP); }
    asm volatile("s_waitcnt lgkmcnt(0)" ::: "memory");
    const u32x4 h0 = *(const LAS u32x4*)(hist + 504 - 8 * lane), h1 = *(const LAS u32x4*)(hist + 508 - 8 * lane);
    const int cnt8 = (int)((h0.x + h0.y) + (h0.z + h0.w) + (h1.x + h1.y) + (h1.z + h1.w));
    const int P = dpp_scan_incl(cnt8);
    const u64 bm = __ballot(P >= 256);
    const int L = __builtin_ctzll(bm);
    int B4, cab;
    { int cum = P - cnt8, bsel = -1, csel = 0;
#define IX_STEP(hv, j) { const int c_ = (int)(hv); if (bsel < 0 && cum + c_ >= 256) { bsel = 511 - 8 * lane - (j); csel = cum; } cum += c_; }
      IX_STEP(h1.w, 0) IX_STEP(h1.z, 1) IX_STEP(h1.y, 2) IX_STEP(h1.x, 3) IX_STEP(h0.w, 4) IX_STEP(h0.z, 5) IX_STEP(h0.y, 6) IX_STEP(h0.x, 7)
#undef IX_STEP
      B4 = __builtin_amdgcn_readlane(bsel, L) * 4; cab = __builtin_amdgcn_readlane(csel, L); }
    int nc = 0; const u64 ltmask = (lane == 0) ? 0ull : (~0ull >> (64 - lane));
#pragma unroll
    for (int r = 0; r < NR; ++r) {
        const bool match = (int)(cvt_u32(fmaf(s[r], c4, o4)) & 0x7fcu) == B4; const u64 m = __ballot(match);
        if (m) { const int pos = nc + __popcll(m & ltmask); int l2 = lane; asm volatile("" : "+v"(l2)); if (match && pos < 64) { cs[pos] = s[r]; ci[pos] = 64 * r + l2; } nc += __popcll(m); }
    }
    if (B4 == 0 || nc > 64) return false;
    asm volatile("s_waitcnt lgkmcnt(0)" ::: "memory");
    const bool act = lane < nc; const float c = act ? cs[lane] : 0.f; const int id = act ? ci[lane] : 0;
    const int kk = 256 - cab;
    int rank = 0;
    for (int j = 0; j < nc; ++j) { const float cj = rdlane(c, j); const int ij = __builtin_amdgcn_readlane(id, j); rank += (cj > c || (cj == c && ij < id)) ? 1 : 0; }
    const u64 tm = __ballot(act && rank == kk - 1);
    const int tl = __builtin_ctzll(tm);
    const float thr = rdlane(c, tl); const int thri = __builtin_amdgcn_readlane(id, tl);
    const bool tie = __popcll(__ballot(act && c == thr)) > 1;
    unsigned mlo = 0u, mhi = 0u;
    if (!tie) OutWords2<NR, false>::template run<0>(s, thr, thri, lane, mlo, mhi); else OutWords2<NR, true>::template run<0>(s, thr, thri, lane, mlo, mhi);
    out = (u64)mlo | ((u64)mhi << 32);
    return true;
}
template <int NR, bool TIE> struct OutWords2 {
    template <int R> static __device__ __forceinline__ void run(const float (&s)[NR], float thr, int thri, int lane, unsigned& mlo, unsigned& mhi) {
        if constexpr (R < NR) {
            int lim = thri - 64 * R; asm("" : "+s"(lim));
            const u64 word = TIE ? __ballot(s[R] > thr || (s[R] == thr && lane <= lim)) : __ballot(s[R] >= thr); put_word<R>(mlo, mhi, word);
            run<R + 1>(s, thr, thri, lane, mlo, mhi);
        }
    }
};
#ifndef IDX_REP_SC
#define IDX_REP_SC 1
#endif
#ifndef IDX_REP_SEL
#define IDX_REP_SEL 1
#endif
template <int REP_SC, int REP_SEL> __device__ __forceinline__ void idx_unit(const Params& p, LAS unsigned char* lds, int b, int g, int tid) {
    typedef float f32x16 __attribute__((ext_vector_type(16)));
    const int lane = tid & 63, r32 = lane & 31, hi = lane >> 5, wid = __builtin_amdgcn_readfirstlane(tid >> 6);
    const int t0 = g * 8; const size_t rowbase = (size_t)b * SEQ;
    u64* mask = (u64*)(p.ws + WS_MASK);
    const int t = t0 + wid;
    if (t0 < 256) {
        const int lo = lane * 64; u64 word = 0ull;
        if (t >= lo + 63) word = ~0ull; else if (t >= lo) word = (~0ull) >> (63 - (t - lo));
        mask[(rowbase + t) * 64 + lane] = word; return;
    }
    const bf16_t* PI = (const bf16_t*)(p.ws + WS_PI); const bf16_t* PB = (const bf16_t*)(p.ws + WS_PB);
    LAS float* sc = (LAS float*)(lds + IX_SC);
    const int nkt_all = ((t0 + 8 + 63) >> 6) * 2;
#pragma unroll 1
    for (int rep = 0; rep < REP_SC; ++rep) {
    bf16x8 aq[2][4];
    { const int ql = 2 * ((r32 >> 2) & 1) + (r32 >> 4), hd = 4 * ((r32 >> 3) & 1) + (r32 & 3);
#pragma unroll
      for (int rt = 0; rt < 2; ++rt) { const bf16_t* qp = PI + (rowbase + t0 + 4 * rt + ql) * LD_PI + hd * 64 + hi * 8;
#pragma unroll
          for (int ks = 0; ks < 4; ++ks) aq[rt][ks] = *(const bf16x8*)(qp + ks * 16); } }
    float wq[2][16];
    { u32x4 wr4[4];
#pragma unroll
      for (int i = 0; i < 4; ++i) wr4[i] = *(const u32x4*)(PB + (rowbase + t0 + 4 * (i >> 1) + 2 * hi + (i & 1)) * LD_PB + PB_WI);
      asm volatile("" : "+v"(wr4[0]), "+v"(wr4[1]), "+v"(wr4[2]), "+v"(wr4[3]));
#pragma unroll
      for (int i = 0; i < 4; ++i) unpack8(wr4[i], &wq[i >> 1][8 * (i & 1)]); }
    const int nkt = nkt_all;
    const bf16_t* kp = (const bf16_t*)(p.ws + WS_KI2) + (size_t)b * 128 * 2048 + lane * 8;
    bf16x8 ka[3][4], kc[3][4];
#define IX_LOAD(dst, kt0) do { _Pragma("unroll") for (int j4 = 0; j4 < 3; ++j4) { const int kt_ = (kt0) + 8 * j4; const int ktc = kt_ < nkt ? kt_ : nkt - 1; \
        _Pragma("unroll") for (int ks = 0; ks < 4; ++ks) dst[j4][ks] = *(const bf16x8*)(kp + (size_t)ktc * 2048 + ks * 512); } } while (0)
#define IX_EPI(acc_, rt_, ktj_) do { float s0 = 0.f, s1 = 0.f; \
            _Pragma("unroll") for (int r = 0; r < 8; ++r) { s0 = fmaf(wq[rt_][r], acc_[r] + __builtin_fabsf(acc_[r]), s0); s1 = fmaf(wq[rt_][8 + r], acc_[8 + r] + __builtin_fabsf(acc_[8 + r]), s1); } \
            const int key = (ktj_) * 32 + r32, qa = t0 + 4 * (rt_) + 2 * hi; const float qnan = __uint_as_float(0x7fc00000u); \
            sc[(4 * (rt_) + 2 * hi) * 4096 + key] = (key <= qa) ? s0 : qnan; sc[(4 * (rt_) + 2 * hi + 1) * 4096 + key] = (key <= qa + 1) ? s1 : qnan; } while (0)
#define IX_COMPUTE(src, kt0) do { _Pragma("unroll") for (int j4 = 0; j4 < 3; ++j4) { const int ktj = (kt0) + 8 * j4; \
        if (ktj < nkt) { f32x16 acc0, acc1; _Pragma("unroll") for (int r = 0; r < 16; ++r) { acc0[r] = 0.f; acc1[r] = 0.f; } \
            _Pragma("unroll") for (int ks = 0; ks < 4; ++ks) acc0 = __builtin_amdgcn_mfma_f32_32x32x16_bf16(aq[0][ks], src[j4][ks], acc0, 0, 0, 0); \
            _Pragma("unroll") for (int ks = 0; ks < 4; ++ks) acc1 = __builtin_amdgcn_mfma_f32_32x32x16_bf16(aq[1][ks], src[j4][ks], acc1, 0, 0, 0); \
            IX_EPI(acc0, 0, ktj); IX_EPI(acc1, 1, ktj); } } } while (0)
    IX_LOAD(ka, wid);
    for (int kt = wid; kt < nkt; kt += 48) {
        IX_LOAD(kc, kt + 24);
        IX_COMPUTE(ka, kt);
        IX_LOAD(ka, kt + 48);
        IX_COMPUTE(kc, kt + 24);
    }
#undef IX_COMPUTE
#undef IX_EPI
#undef IX_LOAD
    }
    const int NR = 16 * ((t0 + 8 + 1023) >> 10);
    { const float qnan = __uint_as_float(0x7fc00000u);
      for (int k = nkt_all * 32 + lane; k < NR * 64; k += 64) sc[wid * 4096 + k] = qnan; }
    __syncthreads();
#pragma unroll 1
    for (int rep = 0; rep < REP_SEL; ++rep) {
        LAS unsigned* hist = (LAS unsigned*)(lds + IX_HIST) + wid * 512; LAS float* cs = (LAS float*)(lds + IX_CAND) + wid * 128; LAS int* ci = (LAS int*)(lds + IX_CAND) + wid * 128 + 64;
        const LAS float* row = sc + wid * 4096; u64 word = 0ull; bool ok;
        if (NR == 16) ok = select_row_fast<16>(row, lane, hist, cs, ci, word);
        else if (NR == 32) ok = select_row_fast<32>(row, lane, hist, cs, ci, word);
        else if (NR == 48) ok = select_row_fast<48>(row, lane, hist, cs, ci, word);
        else ok = select_row_fast<64>(row, lane, hist, cs, ci, word);
        if (!ok) {
            unsigned u[64];
#pragma unroll
            for (int r = 0; r < 64; ++r) { int lim = t - 64 * r; asm("" : "+s"(lim)); u[r] = (lane <= lim) ? fkey(row[64 * r + lane]) : NEGKEY; }
            word = select256(u, lane);
        }
        mask[(rowbase + t) * 64 + lane] = word;
    }
    __syncthreads();
}
__device__ __forceinline__ void phase_idx(const Params& p, const Ctx& C) {
    const int G = C.G, bx = C.bx, vcu = (G % 8 == 0) ? (bx % 8) * (G / 8) + bx / 8 : bx;
    for (int v = vcu; v < 256; v += G) {
        const int b = v >> 5, k = v & 31;
#pragma unroll 1
        for (int j = 0; j < 16; ++j) idx_unit<IDX_REP_SC, IDX_REP_SEL>(p, C.lds, b, ((j & 1) ? 31 - k : k) + 32 * j, C.tid);
    }
    __syncthreads();
}

constexpr size_t WS_LSE = WS_PART + (size_t)3 * T * 384 * 2;
constexpr int DL_K = 0, DL_V = 6 * 8192, DL_WS = 12 * 8192, DL_OST = DL_WS + NWAVES * 256, DL_END = DL_OST + NWAVES * 4096;
__device__ __forceinline__ void dil_unit(const Params& p, LAS unsigned char* lds, int uid, int tid) {
    using namespace fa;
    const int lane = tid & 63, r32 = lane & 31, hi = lane >> 5, wid = __builtin_amdgcn_readfirstlane(tid >> 6);
    const int k16 = uid & 15, pi = (uid >> 4) % 3, bh = uid / 48, b = bh / 6, h = bh % 6;
    const int d = (pi == 0) ? 1 : (pi == 1) ? 4 : 16, nblk = 16 / d, res = k16 / nblk, j = k16 % nblk;
    const size_t rowbase = (size_t)b * SEQ;
    const bf16_t* PB = (const bf16_t*)(p.ws + WS_PB);
    LAS float* wsf = (LAS float*)(lds + DL_WS) + wid * 64; LAS bf16_t* stg = (LAS bf16_t*)(lds + DL_OST) + wid * 2048;
    const int base = 256 * j - 128;
    FA_WAIT_BAR();
#pragma unroll
    for (int u = 0; u < 6; ++u) {
        int ik = base + 64 * u + lane; ik = ik < 0 ? 0 : ik;
        dma_k<8>(PB + (rowbase + res + d * ik) * LD_PB + PB_KB + h * 64, lds + DL_K + u * 8192, wid);
        int iv = base + 64 * u + 16 * (wid & 3) + (lane >> 2); iv = iv < 0 ? 0 : iv;
        dma_v(PB + (rowbase + res + d * iv) * LD_PB + PB_VB + h * 64 + (wid >> 2) * 32 + (lane & 3) * 8, lds + DL_V + u * 8192, wid);
    }
    const int iq = 256 * j + 32 * wid + r32; const size_t mq = rowbase + res + d * iq;
    bf16x8 qr[4];
    { const bf16_t* qw = PB + mq * LD_PB + PB_QB + h * 64 + hi * 8;
#pragma unroll
      for (int d0 = 0; d0 < 4; ++d0) qr[d0] = *(const bf16x8*)(qw + d0 * 16); }
    const float sld = exp2f(-0.8f * (float)(h + 1)) * LOG2E * (float)d;
    const unsigned lim = (unsigned)(iq < 128 ? iq : 128);
    State st; init_state(st);
    FA_WAIT_BAR();
#pragma unroll 1
    for (int uu = 0; uu < 3; ++uu) {
        const int u = (wid >> 1) + uu;
        if (base + 64 * u + 63 < 0) continue;
        const int e0 = iq - base - 64 * u - 4 * hi;
        f32x16 p0, p1;
#pragma unroll
        for (int r = 0; r < 16; ++r) { const int cr = (r & 3) + 8 * (r >> 2); const int d0 = e0 - cr, d1 = e0 - cr - 32;
            p0[r] = ((unsigned)d0 <= lim) ? -sld * (float)d0 : -INFINITY;
            p1[r] = ((unsigned)d1 <= lim) ? -sld * (float)d1 : -INFINITY; }
        qkt<4>(p0, p1, lds + DL_K + u * 8192, qr, r32, hi);
        softmax_pv(st, p0, p1, lds + DL_V + u * 8192, wsf, lane, r32, hi);
    }
    float lse2; finish(st, wsf, stg, r32, hi, &lse2);
    bf16_t* PART = (bf16_t*)(p.ws + WS_PART) + (size_t)pi * T * 384; float* LSE = (float*)(p.ws + WS_LSE) + (size_t)pi * T * 6;
    if (hi == 0) LSE[mq * 6 + h] = lse2;
#pragma unroll
    for (int i = 0; i < 4; ++i) { const int row = i * 8 + (lane >> 3), ch = lane & 7; const size_t m = rowbase + res + d * (256 * j + 32 * wid + row);
        *(u32x4*)(PART + m * 384 + h * 64 + ch * 8) = *(const LAS u32x4*)(stg + row * 64 + ch * 8); }
}
__device__ __forceinline__ void phase_dil(const Params& p, const Ctx& C) {
    const int G = C.G, bx = C.bx, vcu = (G % 8 == 0) ? (bx % 8) * (G / 8) + bx / 8 : bx;
    for (int uid = vcu * 9; uid < 2304; uid += G * 9) {
#pragma unroll 1
        for (int k = 0; k < 9; ++k) dil_unit(p, C.lds, uid + k, C.tid);
    }
    __syncthreads();
}
__device__ __forceinline__ void phase_dilcombine(const Params& p, const Ctx& C) {
    const bf16_t* PART = (const bf16_t*)(p.ws + WS_PART); const float* LSE = (const float*)(p.ws + WS_LSE);
    const bf16_t* PG = (const bf16_t*)(p.ws + WS_PG); bf16_t* Y = (bf16_t*)(p.ws + WS_Y);
    for (int e = C.bx * NTHREADS + C.tid; e < T * 48; e += C.G * NTHREADS) {
        const int m = e / 48, c = e % 48, h = c >> 3;
        const float l0 = LSE[(size_t)m * 6 + h], l1 = LSE[((size_t)T + m) * 6 + h], l2 = LSE[((size_t)2 * T + m) * 6 + h];
        const float mx = fmaxf(l0, fmaxf(l1, l2));
        float w0 = exp2f(l0 - mx), w1 = exp2f(l1 - mx), w2 = exp2f(l2 - mx); const float inv = 1.0f / (w0 + w1 + w2); w0 *= inv; w1 *= inv; w2 *= inv;
        float a[8], bb[8], cc[8], g[8];
        unpack8(*(const u32x4*)(PART + (size_t)m * 384 + c * 8), a); unpack8(*(const u32x4*)(PART + ((size_t)T + m) * 384 + c * 8), bb); unpack8(*(const u32x4*)(PART + ((size_t)2 * T + m) * 384 + c * 8), cc);
        unpack8(*(const u32x4*)(PG + (size_t)m * LD_PG + 384 + c * 8), g);
        float y[8];
#pragma unroll
        for (int i = 0; i < 8; ++i) y[i] = (w0 * a[i] + w1 * bb[i] + w2 * cc[i]) * silu(g[i]);
        u32x4 o; o.x = pk2(y[0], y[1]); o.y = pk2(y[2], y[3]); o.z = pk2(y[4], y[5]); o.w = pk2(y[6], y[7]);
        *(u32x4*)(Y + (size_t)m * DM + 384 + c * 8) = o;
    }
}

typedef unsigned v4u_unused;
#define XB_TMO      128
#define XB_XCNT(j)  (256  + 64 * (j))
#define XB_XSUB(j)  (1280 + 64 * (j))
#define XB_XGEN(j)  (2304 + 64 * (j))
#define XB_TOP      3328
#define XB_TOPGEN   3392
#define XCD_BAR_WORDS 3456
#define XB_SPIN_CAP (1u << 18)

__device__ __forceinline__ unsigned xb_ld(unsigned* p)              { return __hip_atomic_load(p, __ATOMIC_RELAXED, __HIP_MEMORY_SCOPE_AGENT); }
__device__ __forceinline__ unsigned xb_add(unsigned* p, unsigned v) { return __hip_atomic_fetch_add(p, v, __ATOMIC_RELAXED, __HIP_MEMORY_SCOPE_AGENT); }
__device__ __forceinline__ unsigned xb_xcc_id() { return (unsigned)__builtin_amdgcn_s_getreg((3 << 11) | 20) & 0xFu; }
#define XB_SPIN(cond, bar) do { unsigned _sp = 0; while (cond) { __builtin_amdgcn_s_sleep(1); \
    if ((++_sp & 255u) == 0u) { if (xb_ld(&(bar)[XB_TMO])) break; if (_sp > XB_SPIN_CAP) { atomicAdd(&(bar)[XB_TMO], 1u); break; } } } } while (0)

struct XcdBarrier {
    unsigned* bar; unsigned x;
    volatile LAS unsigned* st;
};

__device__ __forceinline__ XcdBarrier xcd_barrier_post(unsigned* bar, volatile LAS unsigned* st, int tid) {
    XcdBarrier b; b.bar = bar; b.x = xb_xcc_id(); b.st = st;
    if (tid == 0) (void)xb_add(&bar[XB_XCNT(b.x)], 1u);
    return b;
}
__device__ __forceinline__ void xcd_barrier_complete(unsigned* bar, unsigned x, unsigned& nloc, unsigned& nx) {
    const unsigned G = gridDim.x * gridDim.y * gridDim.z;
    unsigned sum, cnt, mine, sp = 0u;
    for (;;) {
        sum = 0u; cnt = 0u; mine = 0u;
#pragma unroll
        for (unsigned j = 0; j < 16; ++j) { const unsigned c = xb_ld(&bar[XB_XCNT(j)]); sum += c; cnt += (c > 0u) ? 1u : 0u; mine = (j == x) ? c : mine; }
        if (sum == G) break;
        __builtin_amdgcn_s_sleep(1);
        if ((++sp & 255u) == 0u) { if (xb_ld(&bar[XB_TMO])) break; if (sp > XB_SPIN_CAP) { atomicAdd(&bar[XB_TMO], 1u); break; } }
    }
    nloc = mine > 0u ? mine : 1u; nx = cnt > 0u ? cnt : 1u;
}

__device__ __forceinline__ void xcd_barrier(const XcdBarrier& b, int tid) {
    asm volatile("s_waitcnt vmcnt(0)" ::: "memory");
    __syncthreads();
    if (tid == 0) {
        unsigned* bar = b.bar;
        __builtin_amdgcn_s_waitcnt(0);
        unsigned nloc = b.st[0], nx = b.st[1];
        if (nloc == 0u) { xcd_barrier_complete(bar, b.x, nloc, nx); b.st[0] = nloc; b.st[1] = nx; }
        const unsigned old = xb_add(&bar[XB_XSUB(b.x)], 1u);
        const unsigned gen = old / nloc;
        if (old + 1u == (gen + 1u) * nloc) {
            __builtin_amdgcn_fence(__ATOMIC_RELEASE, "agent");
            asm volatile("s_waitcnt vmcnt(0)" ::: "memory");
            const unsigned og = xb_add(&bar[XB_TOP], 1u);
            const unsigned tg = og / nx;
            if (og + 1u == (tg + 1u) * nx) xb_add(&bar[XB_TOPGEN], 1u);
            else XB_SPIN(xb_ld(&bar[XB_TOPGEN]) == tg, bar);
            __builtin_amdgcn_fence(__ATOMIC_ACQUIRE, "agent");
            xb_add(&bar[XB_XGEN(b.x)], 1u);
            asm volatile("s_waitcnt vmcnt(0)" ::: "memory");
        } else {
            XB_SPIN(xb_ld(&bar[XB_XGEN(b.x)]) == gen, bar);
            __builtin_amdgcn_fence(__ATOMIC_ACQUIRE, "agent");
            asm volatile("s_waitcnt vmcnt(0)" ::: "memory");
        }
    }
    __syncthreads();
}


constexpr int CW_BAR = 4096;
constexpr int LDS_ST_OFF = LDS_BYTES - 64;
__global__ void __launch_bounds__(NTHREADS, 2) mega(Params p) {
    extern __shared__ __attribute__((aligned(16))) unsigned char lds_raw[];
    cg::grid_group grid = cg::this_grid();
    LAS unsigned char* lds = (LAS unsigned char*)lds_raw;
    unsigned* barw = (unsigned*)(p.ws + WS_CTL) + CW_BAR;
    const int wave_s = __builtin_amdgcn_readfirstlane((int)threadIdx.x >> 6);
    { const int tid0 = threadIdx.x;
      if (blockIdx.x == 0) for (int i = tid0; i < XCD_BAR_WORDS; i += NTHREADS) __hip_atomic_store(barw + i, 0u, __ATOMIC_RELAXED, __HIP_MEMORY_SCOPE_AGENT);
      if (tid0 < 16) ((LAS unsigned*)(lds + LDS_ST_OFF))[tid0] = 0u; }
    __syncthreads();
#define CX fresh_ctx(lds, wave_s)
#define PX fresh_params(p)
    phase_prologue(PX, CX);
    __syncthreads(); grid.sync();
    (void)xcd_barrier_post(barw, (volatile LAS unsigned*)(lds + LDS_ST_OFF), CX.tid);
#define GRID_SYNC() do { XcdBarrier xb_; { size_t z_ = 0; asm volatile("" : "+s"(z_)); xb_.bar = (unsigned*)(p.ws + WS_CTL + z_) + CW_BAR; } xb_.x = xb_xcc_id(); xb_.st = (volatile LAS unsigned*)(lds + LDS_ST_OFF); xcd_barrier(xb_, CX.tid); } while (0)
    phase_makeh(PX, CX); GRID_SYNC();
    for (int l = 0; l < DEPTH; ++l) {
        phase_gemm<0>(PX, CX, l); GRID_SYNC();
        phase_gemm<1>(PX, CX, l); phase_gemm<2>(PX, CX, l); __syncthreads();
        phase_idx(PX, CX); phase_dil(PX, CX); GRID_SYNC();
        phase_dilcombine(PX, CX); phase_mla(PX, CX); phase_sparse(PX, CX); GRID_SYNC();
        phase_gemm<3>(PX, CX, l); GRID_SYNC();
        phase_ln(PX, CX, l); if (l + 1 < DEPTH) GRID_SYNC();
    }
}

extern "C" void kernel_launch(void* const* d_in, const int* in_sizes, int n_in, void* d_out, int out_size, void* d_ws, size_t ws_size, hipStream_t stream) {
    static int grid = 0;
    if (grid == 0) {
        if (n_in != 13 || in_sizes[0] != T * DM || out_size != T * DM || ws_size < WS_END) { fprintf(stderr, "kernel_launch: unexpected shapes (n_in %d, in0 %d, out %d, ws %zu)\n", n_in, n_in > 0 ? in_sizes[0] : -1, out_size, ws_size); grid = -1; return; }
        int dev = 0, cus = 0, per_cu = 0;
        if (hipGetDevice(&dev) != hipSuccess || hipDeviceGetAttribute(&cus, hipDeviceAttributeMultiprocessorCount, dev) != hipSuccess) { fprintf(stderr, "kernel_launch: device query failed\n"); grid = -1; return; }
        if (hipFuncSetAttribute((const void*)mega, hipFuncAttributeMaxDynamicSharedMemorySize, LDS_BYTES) != hipSuccess) { fprintf(stderr, "kernel_launch: hipFuncSetAttribute failed\n"); grid = -1; return; }
        if (hipOccupancyMaxActiveBlocksPerMultiprocessor(&per_cu, (const void*)mega, NTHREADS, LDS_BYTES) != hipSuccess || per_cu < 1) { fprintf(stderr, "kernel_launch: occupancy query says %d blocks/CU\n", per_cu); grid = -1; return; }
        grid = cus;
        if (grid < MOD_ITEMS) { fprintf(stderr, "kernel_launch: grid %d too small\n", grid); grid = -1; return; }
    }
    if (grid < 0) return;
    Params p{};
    p.x = (const float*)d_in[0]; p.c = (const float*)d_in[1]; p.w_ada = (const float*)d_in[2]; p.b_ada = (const float*)d_in[3]; p.w_in = (const float*)d_in[4];
    p.qg = (const float*)d_in[5]; p.kvg = (const float*)d_in[6]; p.w_uq = (const float*)d_in[7]; p.w_uk = (const float*)d_in[8]; p.w_uv = (const float*)d_in[9];
    p.w_out = (const float*)d_in[10]; p.ln_g = (const float*)d_in[11]; p.ln_b = (const float*)d_in[12];
    p.out = (float*)d_out; p.ws = (unsigned char*)d_ws; p.layer = 0; p.pad = 0;
    void* args[] = {&p};
    hipError_t e = hipLaunchCooperativeKernel((const void*)mega, dim3(grid), dim3(NTHREADS), args, LDS_BYTES, stream);
    if (e != hipSuccess) fprintf(stderr, "kernel_launch: cooperative launch failed: %s (grid %d)\n", hipGetErrorString(e), grid);
}
```

```cpp
#include <hip/hip_runtime.h>
#include <cstdio>
#include <cstdint>
#include <hip/hip_cooperative_groups.h>
namespace cg = cooperative_groups;

#define LAS __attribute__((address_space(3)))
typedef unsigned short bf16_t;
typedef short bf16x8 __attribute__((ext_vector_type(8)));
typedef float f32x4 __attribute__((ext_vector_type(4)));
typedef unsigned u32x4 __attribute__((ext_vector_type(4)));
typedef unsigned long long u64;

constexpr int NB = 8, SEQ = 4096, DM = 1024, T = NB * SEQ, DEPTH = 2;
constexpr int INW = 4584, NIN = 4608;
constexpr int LD_PA = 1024, LD_PC = 768, LD_PI = 512, LD_PG = 1024;
constexpr int LD_QA = 576, LD_KA = 576, LD_VA = 384;
constexpr float LOG2E = 1.4426950408889634f;
constexpr float QSC64 = 0.125f * LOG2E;
constexpr float QSC96 = 0.10206207261596575f * LOG2E;
constexpr float ALPHA = 1.4142135623730951f;

constexpr size_t MiB = 1u << 20;
constexpr size_t WS_CTL = 0;
constexpr size_t WS_MOD = 1 * MiB;
constexpr size_t WS_ROPE = 1 * MiB + 256 * 1024;
constexpr size_t WS_WIN = 2 * MiB;
constexpr size_t WS_WUQ = 20 * MiB;
constexpr size_t WS_WUKV = 23 * MiB;
constexpr size_t WS_WOUT = 24 * MiB;
constexpr size_t WS_H = 28 * MiB;
constexpr size_t WS_QA = 28 * MiB, WS_VA = 64 * MiB;
constexpr size_t WS_PA = 92 * MiB;
constexpr size_t WS_Y = 92 * MiB;
constexpr size_t WS_QD = 156 * MiB, WS_KD = 180 * MiB, WS_VD = 204 * MiB;
constexpr size_t WS_WI2 = 228 * MiB;
constexpr size_t WS_KI2 = 230 * MiB;
constexpr size_t WS_PC = 236 * MiB;
constexpr size_t WS_PI = 284 * MiB;
constexpr size_t WS_PG = 316 * MiB;
constexpr size_t WS_KA = 380 * MiB;
constexpr size_t WS_MASK = 416 * MiB;
constexpr size_t WS_PART = 432 * MiB;
constexpr size_t WS_SSQ = 507 * MiB;
constexpr size_t WS_END = 509 * MiB;

__device__ __forceinline__ unsigned perm16(unsigned t) { return (t & 15u) * 256u + (t >> 4); }
__device__ __forceinline__ float bf2f(unsigned u) { return __uint_as_float(u << 16); }
__device__ __forceinline__ unsigned f2bf(float f) { unsigned u = __float_as_uint(f); return (u + 0x7fffu + ((u >> 16) & 1u)) >> 16; }
__device__ __forceinline__ unsigned pk2(float lo, float hi) { return f2bf(lo) | (f2bf(hi) << 16); }
__device__ __forceinline__ float silu(float x) { return x / (1.0f + __expf(-x)); }
__device__ __forceinline__ float wave_sum(float v) {
#pragma unroll
    for (int o = 1; o < 64; o <<= 1) v += __shfl_xor(v, o);
    return v;
}
__device__ __forceinline__ float wave_max(float v) {
#pragma unroll
    for (int o = 1; o < 64; o <<= 1) v = fmaxf(v, __shfl_xor(v, o));
    return v;
}
__device__ __forceinline__ int wave_sum_i(int v) {
#pragma unroll
    for (int o = 1; o < 64; o <<= 1) v += __shfl_xor(v, o);
    return v;
}
__device__ __forceinline__ void unpack8(const u32x4 v, float* f) {
    f[0] = bf2f(v.x & 0xffffu); f[1] = __uint_as_float(v.x & 0xffff0000u);
    f[2] = bf2f(v.y & 0xffffu); f[3] = __uint_as_float(v.y & 0xffff0000u);
    f[4] = bf2f(v.z & 0xffffu); f[5] = __uint_as_float(v.z & 0xffff0000u);
    f[6] = bf2f(v.w & 0xffffu); f[7] = __uint_as_float(v.w & 0xffff0000u);
}

namespace pg8 {
constexpr int BM = 256, BK = 64, HALF = 128, HTB = HALF * BK * 2, STAGE_BYTES = 8 * HTB, NXCD = 8, WGM = 8;
__host__ __device__ __forceinline__ int lds_byte(int r, int c) { const int st = (r >> 4) * 2 + (c >> 5), rr = r & 15, cc = c & 31, ob = rr * 64 + cc * 2; return st * 1024 + (ob ^ (((ob >> 9) & 1) << 5)); }
__host__ __device__ __forceinline__ void stage_rc(int b, int& R, int& C) { const int st = b / 1024, sb = b % 1024, swz = sb ^ (((sb >> 9) & 1) << 5); R = (st >> 1) * 16 + swz / 64; C = (st & 1) * 32 + (swz % 64) / 2; }
__host__ __device__ __forceinline__ int perm32(int rho) { const int n = rho >> 4, i = rho & 15; return 8 * (i >> 2) + 4 * n + (i & 3); }

struct Unit { int pm, pn; };
struct Gemm { const bf16_t* A; const bf16_t* Bt; int M, N, K, lda, ldb; };

struct StaticOrder {
    int nM, nN, nwg, G, c;
    __host__ __device__ void init(int M, int N, int G_, int c_) { nM = M / BM; nN = N / BM; nwg = nM * nN; G = G_; c = c_; }
    __host__ __device__ bool next(int i, Unit& u) const {
        const long L = (long)i * G + c; if (L >= nwg) return false;
        int wgid = (int)L; { const int q = nwg / NXCD, r = nwg % NXCD, xcd = wgid % NXCD, off = wgid / NXCD; wgid = (xcd < r ? xcd * (q + 1) : r * (q + 1) + (xcd - r) * q) + off; }
        const int nig = WGM * nN, gid = wgid / nig, fm = gid * WGM, gsz = (nM - fm) < WGM ? (nM - fm) : WGM;
        u.pm = fm + ((wgid % nig) % gsz); u.pn = (wgid % nig) / gsz; return true;
    }
};

struct PanelSched { int pm, pn0, n;
    __host__ __device__ bool next(int i, Unit& u) const { if (i >= n) return false; u.pm = pm; u.pn = pn0 + i; return true; } };

template <class F> struct EpiChunk {
    static constexpr bool PERM = true;
    F f;
    __device__ __forceinline__ void operator()(const f32x4 (&acc)[2][2][4][2], const Unit& u, int wr, int wc, int fr, int fq) const {
        const int row0 = u.pm * BM + wr * 64 + fr, col0 = u.pn * BM + wc * 32 + 8 * fq;
#pragma unroll
        for (int ai = 0; ai < 2; ++ai)
#pragma unroll
            for (int m = 0; m < 4; ++m) { const int row = row0 + ai * HALF + m * 16; const float rs = f.row(row);
#pragma unroll
                for (int bj = 0; bj < 2; ++bj) f(row, col0 + bj * HALF, acc[ai][bj][m][0], acc[ai][bj][m][1], rs);
                asm volatile("" ::: "memory"); }
    }
};

template <class Epi, class Sched, bool ALIGN_EPI>
__device__ __forceinline__ void gemm_phase(LAS unsigned char* lds, const Gemm g, const Sched& S, const Epi& E, int tid) {
    asm volatile("" : "+v"(tid));
    const int wid = __builtin_amdgcn_readfirstlane(tid >> 6), lane = tid & 63, wr = wid >> 2, wc = wid & 3, fr = lane & 15, fq = lane >> 4;
    const int K = g.K, nt = K / BK;
    unsigned voffA[2], voffB[2];
#pragma unroll
    for (int i = 0; i < 2; ++i) { int R, C; stage_rc(tid * 16 + i * 8192, R, C); const int Rb = Epi::PERM ? ((R & ~31) + perm32(R & 31)) : R;
        voffA[i] = (unsigned)(R * g.lda + C) * 2u; voffB[i] = (unsigned)(Rb * g.ldb + C) * 2u; }
    const size_t kstep = (size_t)(BK * 2);
    const size_t hsA = (size_t)HALF * g.lda * 2, hsB = (size_t)HALF * g.ldb * 2;
    const size_t tsA = 2 * hsA, tsB = 2 * hsB;
    const unsigned ldsw = (unsigned)wid * 1024u;
    const int aoff = lds_byte(wr * 64 + fr, fq * 8), boff = lds_byte(wc * 32 + fr, fq * 8);
#define PG8_SA(b, h) (((b) * 2 + (h)) * HTB)
#define PG8_SB(b, h) ((4 + (b) * 2 + (h)) * HTB)
#define PG8_STAGE(bufoff, gbase, voff) do { _Pragma("unroll") for (int _i = 0; _i < 2; ++_i) \
        __builtin_amdgcn_global_load_lds((const unsigned*)((const char*)(gbase) + (voff)[_i]), (LAS unsigned*)(lds + (bufoff) + ldsw + _i * 8192), 16, 0, 0); } while (0)
#define PG8_LDA(dst, b, h) do { _Pragma("unroll") for (int m = 0; m < 4; ++m) _Pragma("unroll") for (int k = 0; k < 2; ++k) dst[m][k] = *(const LAS bf16x8*)(lds + PG8_SA(b, h) + aoff + m * 2048 + k * 1024); } while (0)
#define PG8_LDB(dst, b, h) do { _Pragma("unroll") for (int n = 0; n < 2; ++n) _Pragma("unroll") for (int k = 0; k < 2; ++k) dst[n][k] = *(const LAS bf16x8*)(lds + PG8_SB(b, h) + boff + n * 2048 + k * 1024); } while (0)
#define PG8_MMA(ai, bj, At, Bt) do { __builtin_amdgcn_s_setprio(1); _Pragma("unroll") for (int m = 0; m < 4; ++m) _Pragma("unroll") for (int n = 0; n < 2; ++n) _Pragma("unroll") for (int k = 0; k < 2; ++k) \
        acc[ai][bj][m][n] = __builtin_amdgcn_mfma_f32_16x16x32_bf16(Bt[n][k], At[m][k], acc[ai][bj][m][n], 0, 0, 0); __builtin_amdgcn_s_setprio(0); } while (0)
#define PG8_WAIT_V(n) asm volatile("s_waitcnt vmcnt(" #n ")" ::: "memory")
#define PG8_WAIT_L(n) asm volatile("s_waitcnt lgkmcnt(" #n ")" ::: "memory")
#define PG8_BAR __builtin_amdgcn_s_barrier()
#define PG8_SCHED __builtin_amdgcn_sched_barrier(0)
    Unit cur, nxt; int ui = 0;
    if (!S.next(0, cur)) return;
    f32x4 acc[2][2][4][2];
#pragma unroll
    for (int a = 0; a < 2; ++a)
#pragma unroll
        for (int b = 0; b < 2; ++b)
#pragma unroll
            for (int m = 0; m < 4; ++m)
#pragma unroll
                for (int n = 0; n < 2; ++n) acc[a][b][m][n] = (f32x4){0.f, 0.f, 0.f, 0.f};
    bf16x8 At[4][2], B0[2][2], B1[2][2];
    const char* cA = (const char*)g.A + (size_t)cur.pm * tsA; const char* cB = (const char*)g.Bt + (size_t)cur.pn * tsB;
    PG8_STAGE(PG8_SB(0, 0), cB, voffB); PG8_STAGE(PG8_SB(0, 1), cB + hsB, voffB); PG8_STAGE(PG8_SA(0, 0), cA, voffA); PG8_STAGE(PG8_SA(0, 1), cA + hsA, voffA);
    if (wr == 1) PG8_BAR;
    PG8_WAIT_V(2); PG8_BAR;
    PG8_STAGE(PG8_SB(1, 0), cB + kstep, voffB); PG8_STAGE(PG8_SA(1, 0), cA + kstep, voffA); PG8_STAGE(PG8_SB(1, 1), cB + hsB + kstep, voffB);
    PG8_WAIT_V(6); PG8_BAR;
    for (;;) {
        const bool has_next = S.next(ui + 1, nxt);
        const char* nA = has_next ? (const char*)g.A + (size_t)nxt.pm * tsA : cA; const char* nB = has_next ? (const char*)g.Bt + (size_t)nxt.pn * tsB : cB;
#pragma nounroll
        for (int t = 0; t < nt; t += 2) {
            const bool last = (t == nt - 2);
            const char* a1 = cA + (size_t)(t + 1) * kstep;
            const char* a2 = last ? nA : cA + (size_t)(t + 2) * kstep; const char* b2 = last ? nB : cB + (size_t)(t + 2) * kstep;
            const char* a3 = a2 + kstep; const char* b3 = b2 + kstep;
            PG8_LDB(B0, 0, 0); PG8_LDB(B1, 0, 1); PG8_SCHED; PG8_LDA(At, 0, 0); PG8_STAGE(PG8_SA(1, 1), a1 + hsA, voffA);
            PG8_WAIT_V(8); PG8_WAIT_L(0); PG8_BAR; PG8_MMA(0, 0, At, B0); PG8_MMA(0, 1, At, B1); PG8_BAR; PG8_SCHED;
            PG8_LDA(At, 0, 1); PG8_STAGE(PG8_SB(0, 0), b2, voffB); PG8_STAGE(PG8_SB(0, 1), b2 + hsB, voffB); PG8_STAGE(PG8_SA(0, 0), a2, voffA);
            PG8_WAIT_V(8); PG8_WAIT_L(0); PG8_BAR; PG8_MMA(1, 0, At, B0); PG8_MMA(1, 1, At, B1); PG8_BAR; PG8_SCHED;
            PG8_LDB(B0, 1, 0); PG8_LDB(B1, 1, 1); PG8_SCHED; PG8_LDA(At, 1, 0); PG8_STAGE(PG8_SA(0, 1), a2 + hsA, voffA);
            PG8_WAIT_V(8); PG8_WAIT_L(0); PG8_BAR; PG8_MMA(0, 0, At, B0); PG8_MMA(0, 1, At, B1); PG8_BAR; PG8_SCHED;
            PG8_LDA(At, 1, 1); PG8_STAGE(PG8_SB(1, 0), b3, voffB); PG8_STAGE(PG8_SB(1, 1), b3 + hsB, voffB); PG8_STAGE(PG8_SA(1, 0), a3, voffA);
            PG8_WAIT_V(8); PG8_WAIT_L(0); PG8_BAR; PG8_MMA(1, 0, At, B0); PG8_MMA(1, 1, At, B1); PG8_BAR; PG8_SCHED;
        }
        if constexpr (ALIGN_EPI) { if (wr == 0) PG8_BAR; }
        E(acc, cur, wr, wc, fr, fq);
        if (!has_next) break;
#pragma unroll
        for (int a = 0; a < 2; ++a)
#pragma unroll
            for (int b = 0; b < 2; ++b)
#pragma unroll
                for (int m = 0; m < 4; ++m)
#pragma unroll
                    for (int n = 0; n < 2; ++n) acc[a][b][m][n] = (f32x4){0.f, 0.f, 0.f, 0.f};
        cur = nxt; cA = nA; cB = nB; ++ui;
        if constexpr (ALIGN_EPI) { if (wr == 1) PG8_BAR; }
    }
    PG8_WAIT_V(0);
    if constexpr (!ALIGN_EPI) { if (wr == 0) PG8_BAR; }
    PG8_BAR;
#undef PG8_SA
#undef PG8_SB
#undef PG8_STAGE
#undef PG8_LDA
#undef PG8_LDB
#undef PG8_MMA
#undef PG8_WAIT_V
#undef PG8_WAIT_L
#undef PG8_BAR
#undef PG8_SCHED
}
}

struct Params {
    const float* x; const float* c; const float* w_ada; const float* b_ada; const float* w_in; const float* qg; const float* kvg;
    const float* w_uq; const float* w_uk; const float* w_uv; const float* w_out; const float* ln_g; const float* ln_b;
    float* out; unsigned char* ws; int layer; int pad;
};

constexpr int NWAVES = 8, NTHREADS = 512;
constexpr int LDS_BYTES = 152 * 1024;
struct Ctx { LAS unsigned char* lds; int tid, lane, wave, gw, ngw, bx, G; };
__device__ __forceinline__ Params fresh_params(const Params& p) { Params q = p; size_t z = 0; asm volatile("" : "+s"(z)); q.ws = p.ws + z; q.out = p.out + z; return q; }
__device__ __forceinline__ Ctx fresh_ctx(LAS unsigned char* lds, int wave_s) {
    Ctx C; C.lds = lds; asm volatile("" : "+s"(wave_s)); int ln; asm volatile("v_mbcnt_lo_u32_b32 %0, -1, 0\n\tv_mbcnt_hi_u32_b32 %0, -1, %0" : "=v"(ln));
    const int t = wave_s * 64 + ln; C.tid = t; C.lane = ln; C.wave = wave_s;
    int bx = blockIdx.x, G = gridDim.x; asm volatile("" : "+s"(bx)); asm volatile("" : "+s"(G)); C.bx = bx; C.G = G;
    C.gw = bx * NWAVES + C.wave; C.ngw = G * NWAVES; return C; }

__device__ __forceinline__ int map_in(int n, float& sc) {
    sc = 1.f;
    if (n < 1024) return n;
    if (n < 2304) { const int j = n - 1024;
        if (j < 384) { sc = QSC64; return 1056 + j; }
        if (j < 768) return 1440 + (j - 384);
        if (j < 1152) return 1824 + (j - 768);
        if (j < 1184) { const int w = j - 1152; return 1024 + (w >> 1) + 16 * (w & 1); }
        if (j < 1248) return 3488 + (j - 1184);
        if (j < 1256) return 3552 + (j - 1248);
        return -1; }
    if (n < 3072) { const int j = n - 2304; if (j < 256) sc = QSC64; return 2208 + j; }
    if (n < 3584) return 2976 + (n - 3072);
    return 3560 + (n - 3584);
}
constexpr int PT_IN = 72 * 16, PT_UQ = 12 * 12, PT_UKV = 12 * 4, PT_OUT = 16 * 16, PT_L = PT_IN + PT_UQ + PT_UKV + PT_OUT, PREP_TILES = 2 * PT_L;
__device__ __forceinline__ void prep_tile(const Params& p, int tile, LAS float* tl  , int tid) {
    const int l = tile / PT_L; int r = tile % PT_L;
    int kind, K;
    if (r < PT_IN) { kind = 0; K = 1024; } else if ((r -= PT_IN) < PT_UQ) { kind = 1; K = 768; } else if ((r -= PT_UQ) < PT_UKV) { kind = 2; K = 256; } else { r -= PT_UKV; kind = 3; K = 1024; }
    const int nkb = K / 64, n0 = (r / nkb) * 64, k0 = (r % nkb) * 64;
    const int i = tid & 63, j = tid >> 6, n = n0 + i;
    const float* src = nullptr; int srcN = 0, scol = -1; float cs = 1.f; const float* ks = nullptr; bf16_t* dst = nullptr;
    if (kind == 0) { src = p.w_in + (size_t)l * 1024 * INW; srcN = INW; scol = map_in(n, cs); dst = (bf16_t*)(p.ws + WS_WIN) + (size_t)l * NIN * 1024; }
    else if (kind == 1) { src = p.w_uq + (size_t)l * 768 * 576; srcN = 576; ks = p.qg + l * 768; cs = QSC96; dst = (bf16_t*)(p.ws + WS_WUQ) + (size_t)l * 768 * 768;
        if (n < 576) { const int h = n / 96, w = n % 96; scol = (w < 64) ? 96 * h + w : 96 * h + 64 + ((w - 64) >> 1) + 16 * ((w - 64) & 1); } }
    else if (kind == 2) { ks = p.kvg + l * 256; dst = (bf16_t*)(p.ws + WS_WUKV) + (size_t)l * 768 * 256; srcN = 384;
        if (n < 384) { src = p.w_uk + (size_t)l * 256 * 384; scol = n; } else { src = p.w_uv + (size_t)l * 256 * 384; scol = n - 384; } }
    else { src = p.w_out + (size_t)l * 1024 * 1024; srcN = 1024; scol = n; dst = (bf16_t*)(p.ws + WS_WOUT) + (size_t)l * 1024 * 1024; }
#pragma unroll
    for (int kk = j; kk < 64; kk += 8) { const int k = k0 + kk; float v = 0.f; if (scol >= 0) { v = src[(size_t)k * srcN + scol] * cs; if (ks) v *= ks[k]; } tl[kk * 65 + i] = v; }
    __syncthreads();
    { const int nn = tid >> 3, kc = tid & 7; u32x4 o;
      o.x = pk2(tl[(kc * 8 + 0) * 65 + nn], tl[(kc * 8 + 1) * 65 + nn]); o.y = pk2(tl[(kc * 8 + 2) * 65 + nn], tl[(kc * 8 + 3) * 65 + nn]);
      o.z = pk2(tl[(kc * 8 + 4) * 65 + nn], tl[(kc * 8 + 5) * 65 + nn]); o.w = pk2(tl[(kc * 8 + 6) * 65 + nn], tl[(kc * 8 + 7) * 65 + nn]);
      *(u32x4*)(dst + (size_t)(n0 + nn) * K + k0 + kc * 8) = o; }
    __syncthreads();
}
constexpr int MOD_ITEMS = 2 * 48;
__device__ __forceinline__ void mod_item(const Params& p, int item, LAS float* sc  , LAS float* part  , int tid) {
    const int l = item / 48, j0 = (item % 48) * 64, col = tid & 63, kg = tid >> 6;
    float acc[NB];
#pragma unroll
    for (int b = 0; b < NB; ++b) acc[b] = 0.f;
    const float* w = p.w_ada + (size_t)l * 1024 * 3072 + j0 + col;
    for (int k = kg * 128; k < kg * 128 + 128; ++k) { const float wv = w[(size_t)k * 3072];
#pragma unroll
        for (int b = 0; b < NB; ++b) acc[b] += sc[b * 1024 + k] * wv; }
#pragma unroll
    for (int b = 0; b < NB; ++b) part[(kg * 8 + b) * 64 + col] = acc[b];
    __syncthreads();
    { const int b = tid >> 6; float s = p.b_ada[l * 3072 + j0 + col];
#pragma unroll
      for (int g = 0; g < 8; ++g) s += part[(g * 8 + b) * 64 + col];
      ((float*)(p.ws + WS_MOD))[((size_t)l * NB + b) * 3072 + j0 + col] = s; }
    __syncthreads();
}
__device__ __forceinline__ void rope_entry(int pos, int i, float& c, float& s) {
    const float th = exp2f(-(float)i * (13.287712379549449f / 16.0f));
    const float angf = (float)pos * th;
    const double a = (double)angf, n = rint(a * 0.15915494309189535), r = (a - n * 6.283185307179586) - n * 2.4492935982947064e-16;
    const double r2 = r * r; double sn = 0.0, cs = 0.0, ts = r, tc = 1.0;
#pragma unroll
    for (int k = 0; k < 14; ++k) { sn += ts; cs += tc; tc = -tc * r2 / (double)((2 * k + 1) * (2 * k + 2)); ts = -ts * r2 / (double)((2 * k + 2) * (2 * k + 3)); }
    c = (float)cs; s = (float)sn;
}
__device__ __forceinline__ void phase_prologue(const Params& p, const Ctx& C) {
    LAS float* tl = (LAS float*)C.lds;
    for (int t = C.bx; t < PREP_TILES; t += C.G) prep_tile(p, t, tl, C.tid);
    if (C.bx < MOD_ITEMS) {
        LAS float* sc = (LAS float*)C.lds; LAS float* part = sc + NB * 1024;
        for (int e = C.tid; e < NB * 1024; e += NTHREADS) sc[e] = silu(p.c[e]);
        __syncthreads();
        mod_item(p, C.bx, sc, part, C.tid);
    }
    float* tab = (float*)(p.ws + WS_ROPE);
    for (int e = C.bx * NTHREADS + C.tid; e < SEQ * 16; e += C.G * NTHREADS) { float c, s; rope_entry(e >> 4, e & 15, c, s); tab[2 * e] = c; tab[2 * e + 1] = s; }
}
__device__ __forceinline__ void phase_makeh(const Params& p, const Ctx& C) {
    for (size_t e = ((size_t)C.bx * NTHREADS + C.tid) * 8; e < (size_t)T * DM; e += (size_t)C.G * NTHREADS * 8) {
        const int m = (int)(e >> 10), k = (int)(e & 1023), b = m / SEQ;
        const float* mod = (const float*)(p.ws + WS_MOD) + (size_t)b * 3072;
        const f32x4 x0 = *(const f32x4*)(p.x + e), x1 = *(const f32x4*)(p.x + e + 4);
        const f32x4 sh0 = *(const f32x4*)(mod + k), sh1 = *(const f32x4*)(mod + k + 4), s0 = *(const f32x4*)(mod + 1024 + k), s1 = *(const f32x4*)(mod + 1024 + k + 4);
        const f32x4 h0 = x0 * (s0 + 1.0f) + sh0, h1 = x1 * (s1 + 1.0f) + sh1;
        u32x4 o; o.x = pk2(h0.x, h0.y); o.y = pk2(h0.z, h0.w); o.z = pk2(h1.x, h1.y); o.w = pk2(h1.z, h1.w);
        *(u32x4*)((bf16_t*)(p.ws + WS_H) + e) = o;
    }
}
__device__ __forceinline__ u32x4 pack8(f32x4 v0, f32x4 v1) { u32x4 w; w.x = pk2(v0[0], v0[1]); w.y = pk2(v0[2], v0[3]); w.z = pk2(v1[0], v1[1]); w.w = pk2(v1[2], v1[3]); return w; }
__device__ __forceinline__ float ssq8(const u32x4 w) { float f[8]; unpack8(w, f); return ((f[0] * f[0] + f[1] * f[1]) + (f[2] * f[2] + f[3] * f[3])) + ((f[4] * f[4] + f[5] * f[5]) + (f[6] * f[6] + f[7] * f[7])); }
struct EpiIn {
    static constexpr bool PERM = true;
    unsigned char* ws;
    __device__ __forceinline__ void operator()(const f32x4 (&acc)[2][2][4][2], const pg8::Unit& u, int wr, int wc, int fr, int fq) const {
        using namespace pg8;
        const int pn = u.pn, row0 = u.pm * BM + wr * 64 + fr, colt = wc * 32 + 8 * fq; unsigned base, ld, c0;
        if (pn < 4) { base = (unsigned)WS_PA; ld = LD_PA; c0 = pn * 256; }
        else if (pn < 9) { base = 0u; ld = 0u; c0 = (pn - 4) * 256; }
        else if (pn < 12) { base = (unsigned)WS_PC; ld = LD_PC; c0 = (pn - 9) * 256; }
        else if (pn < 14) { base = (unsigned)WS_PI; ld = LD_PI; c0 = (pn - 12) * 256; }
        else { base = (unsigned)WS_PG; ld = LD_PG; c0 = (pn - 14) * 256; }
        const bool t8 = (pn == 8);
#pragma unroll
        for (int ai = 0; ai < 2; ++ai)
#pragma unroll
            for (int m = 0; m < 4; ++m) { const int row = row0 + ai * HALF + m * 16; float ssq = 0.f;
#pragma unroll
                for (int bj = 0; bj < 2; ++bj) { f32x4 v0 = acc[ai][bj][m][0], v1 = acc[ai][bj][m][1];
                    if (bj == 1 && t8) {
                        if (wc == 0) {
                            const unsigned pos = (unsigned)row % SEQ, to = (unsigned)WS_ROPE + (pos * 16u + 4u * fq) * 8u;
                            const f32x4 t0 = *(const f32x4*)(ws + to), t1 = *(const f32x4*)(ws + to + 16u);
                            f32x4 a, b;
                            a[0] = v0[0] * t0[0] - v0[1] * t0[1]; a[1] = v0[0] * t0[1] + v0[1] * t0[0];
                            a[2] = v0[2] * t0[2] - v0[3] * t0[3]; a[3] = v0[2] * t0[3] + v0[3] * t0[2];
                            b[0] = v1[0] * t1[0] - v1[1] * t1[1]; b[1] = v1[0] * t1[1] + v1[1] * t1[0];
                            b[2] = v1[2] * t1[2] - v1[3] * t1[3]; b[3] = v1[2] * t1[3] + v1[3] * t1[2];
                            const u32x4 w = pack8(a, b); const unsigned ko = (unsigned)WS_KA + ((unsigned)row * LD_KA + 64u + 8u * fq) * 2u;
#pragma unroll
                            for (int h = 0; h < 6; ++h) *(u32x4*)(ws + ko + h * 192u) = w;
                        } else if (wc < 3) {
                            const unsigned d8 = (unsigned)(wc - 1) * 4u + fq;
                            *(u32x4*)(ws + ((unsigned)WS_KI2 + ((unsigned)row >> 5) * 4096u + (d8 >> 1) * 1024u + (d8 & 1u) * 512u + ((unsigned)row & 31u) * 16u)) = pack8(v0, v1);
                        } else if (fq == 0) {
                            *(u32x4*)(ws + ((unsigned)WS_WI2 + (unsigned)row * 16u)) = pack8(v0, v1);
                        }
                    } else if (pn >= 4 && pn < 9) {
                        const unsigned jc = c0 + colt + bj * HALF;
                        const unsigned which = jc / 384u, hh = (jc % 384u) >> 6, bb = (unsigned)row / SEQ, tt = (unsigned)row % SEQ;
                        *(u32x4*)(ws + ((unsigned)WS_QD + which * (unsigned)(WS_KD - WS_QD) + (((bb * 6u + hh) * SEQ + perm16(tt)) * 64u + (jc & 63u)) * 2u)) = pack8(v0, v1);
                    } else {
                        const u32x4 w = pack8(v0, v1);
                        *(u32x4*)(ws + (base + ((unsigned)row * ld + c0 + colt + bj * HALF) * 2u)) = w;
                        if (pn < 4) ssq += ssq8(w);
                    } }
                if (pn < 4) { ssq += __shfl_xor(ssq, 16); ssq += __shfl_xor(ssq, 32);
                    if (fq == 0) *(float*)(ws + ((unsigned)WS_SSQ + ((unsigned)row * 16u + pn * 4u + wc) * 4u)) = ssq; }
                asm volatile("" ::: "memory"); }
    }
};
struct FUq { unsigned char* ws; const LAS float* rsl;
    __device__ __forceinline__ float row(int row) const { return rsl[(row & 255) * 2]; }
    __device__ __forceinline__ void operator()(int row, int col, f32x4 v0, f32x4 v1, float r) const {
        if (col >= 576) return;
        v0 = v0 * r; v1 = v1 * r;
        const int w = col % 96;
        if (w >= 64) { const unsigned i0 = (unsigned)(w - 64) >> 1, pos = (unsigned)row % SEQ; const unsigned to = (unsigned)WS_ROPE + (pos * 16u + i0) * 8u;
            const f32x4 t0 = *(const f32x4*)(ws + to), t1 = *(const f32x4*)(ws + to + 16u);
            f32x4 a, b;
            a[0] = v0[0] * t0[0] - v0[1] * t0[1]; a[1] = v0[0] * t0[1] + v0[1] * t0[0];
            a[2] = v0[2] * t0[2] - v0[3] * t0[3]; a[3] = v0[2] * t0[3] + v0[3] * t0[2];
            b[0] = v1[0] * t1[0] - v1[1] * t1[1]; b[1] = v1[0] * t1[1] + v1[1] * t1[0];
            b[2] = v1[2] * t1[2] - v1[3] * t1[3]; b[3] = v1[2] * t1[3] + v1[3] * t1[2];
            v0 = a; v1 = b; }
        *(u32x4*)(ws + ((unsigned)WS_QA + ((unsigned)row * LD_QA + (unsigned)col) * 2u)) = pack8(v0, v1);
    }
};
struct FUkv { unsigned char* ws; const LAS float* rsl;
    __device__ __forceinline__ float row(int row) const { return rsl[(row & 255) * 2 + 1]; }
    __device__ __forceinline__ void operator()(int row, int col, f32x4 v0, f32x4 v1, float r) const {
        v0 = v0 * r; v1 = v1 * r;
        const unsigned off = (col < 384) ? (unsigned)WS_KA + ((unsigned)row * LD_KA + (unsigned)((col >> 6) * 96 + (col & 63))) * 2u
                                         : (unsigned)WS_VA + ((unsigned)row * LD_VA + (unsigned)(col - 384)) * 2u;
        *(u32x4*)(ws + off) = pack8(v0, v1);
    }
};
struct FOut { const float* xin; float* out; const float* mod;
    __device__ __forceinline__ float row(int) const { return 0.f; }
    __device__ __forceinline__ void operator()(int row, int col, f32x4 v0, f32x4 v1, float) const {
        const unsigned b = (unsigned)row / SEQ; const unsigned go = (b * 3072u + 2048u + (unsigned)col) * 4u;
        const f32x4 g0 = *(const f32x4*)((const char*)mod + go), g1 = *(const f32x4*)((const char*)mod + go + 16u);
        const unsigned off = ((unsigned)row * DM + (unsigned)col) * 4u;
        const f32x4 x0 = *(const f32x4*)((const char*)xin + off), x1 = *(const f32x4*)((const char*)xin + off + 16u);
        *(f32x4*)((char*)out + off) = x0 * ALPHA + (g0 + 1.0f) * v0; *(f32x4*)((char*)out + off + 16u) = x1 * ALPHA + (g1 + 1.0f) * v1;
    }
};
constexpr int RS_OFF = pg8::STAGE_BYTES;
__device__ __forceinline__ void phase_rs(const Params& p, const Ctx& C) {
    const int vcu = (C.G % 8 == 0) ? (C.bx % 8) * (C.G / 8) + C.bx / 8 : C.bx, pm = vcu >> 1;
    LAS float* rsl = (LAS float*)(C.lds + RS_OFF);
    const int row = C.tid >> 1, part = C.tid & 1;
    const f32x4* q = (const f32x4*)(p.ws + WS_SSQ) + (size_t)(pm * 256 + row) * 4;
    if (part == 0) { const f32x4 a = q[0], b = q[1], c = q[2];
        rsl[row * 2] = rsqrtf((((a[0] + a[1]) + (a[2] + a[3])) + ((b[0] + b[1]) + (b[2] + b[3])) + ((c[0] + c[1]) + (c[2] + c[3]))) * (1.0f / 768.0f) + 1e-6f); }
    else { const f32x4 a = q[3]; rsl[row * 2 + 1] = rsqrtf(((a[0] + a[1]) + (a[2] + a[3])) * (1.0f / 256.0f) + 1e-6f); }
    __syncthreads();
}
template <int WHICH> __device__ __forceinline__ void phase_gemm(const Params& p, const Ctx& C, int l) {
    pg8::StaticOrder S; const int vcu = (C.G % 8 == 0) ? (C.bx % 8) * (C.G / 8) + C.bx / 8 : C.bx; (void)vcu;
    if constexpr (WHICH == 0) {
        pg8::Gemm g{(const bf16_t*)(p.ws + WS_H), (const bf16_t*)(p.ws + WS_WIN) + (size_t)l * NIN * 1024, T, NIN, 1024, 1024, 1024};
        S.init(T, NIN, C.G, C.bx); EpiIn E{p.ws};
        pg8::gemm_phase<EpiIn, pg8::StaticOrder, true>(C.lds, g, S, E, C.tid);
    } else if constexpr (WHICH == 1) {
        pg8::Gemm g{(const bf16_t*)(p.ws + WS_PA), (const bf16_t*)(p.ws + WS_WUQ) + (size_t)l * 768 * 768, T, 768, 768, LD_PA, 768};
        pg8::EpiChunk<FUq> E{FUq{p.ws, (const LAS float*)(C.lds + RS_OFF)}};
        { const int v = vcu; const pg8::PanelSched PS{v >> 1, (v & 1) ? 2 : 0, (v & 1) ? 1 : 2};
            pg8::gemm_phase<pg8::EpiChunk<FUq>, pg8::PanelSched, true>(C.lds, g, PS, E, C.tid); }
    } else if constexpr (WHICH == 2) {
        pg8::Gemm g{(const bf16_t*)(p.ws + WS_PA) + 768, (const bf16_t*)(p.ws + WS_WUKV) + (size_t)l * 768 * 256, T, 768, 256, LD_PA, 256};
        pg8::EpiChunk<FUkv> E{FUkv{p.ws, (const LAS float*)(C.lds + RS_OFF)}};
        { const int v = vcu; const pg8::PanelSched PS{v >> 1, 0, (v & 1) ? 3 : 0};
            pg8::gemm_phase<pg8::EpiChunk<FUkv>, pg8::PanelSched, true>(C.lds, g, PS, E, C.tid); }
    } else {
        pg8::Gemm g{(const bf16_t*)(p.ws + WS_Y), (const bf16_t*)(p.ws + WS_WOUT) + (size_t)l * 1024 * 1024, T, 1024, 1024, 1024, 1024};
        S.init(T, 1024, C.G, C.bx);
        pg8::EpiChunk<FOut> E{FOut{l == 0 ? p.x : p.out, p.out, (const float*)(p.ws + WS_MOD) + (size_t)l * NB * 3072}};
        pg8::gemm_phase<pg8::EpiChunk<FOut>, pg8::StaticOrder, true>(C.lds, g, S, E, C.tid);
    }
}
__device__ __forceinline__ void phase_ln(const Params& p, const Ctx& C, int l) {
    const int lane = C.lane;
    for (int m = C.gw; m < T; m += C.ngw) {
        float* row = p.out + (size_t)m * DM;
        f32x4 v[4]; float s = 0.f;
#pragma unroll
        for (int j = 0; j < 4; ++j) { v[j] = *(const f32x4*)(row + j * 256 + lane * 4); s += (v[j].x + v[j].y) + (v[j].z + v[j].w); }
        const float mean = wave_sum(s) * (1.0f / DM); float s2 = 0.f;
#pragma unroll
        for (int j = 0; j < 4; ++j) { v[j] = v[j] - mean; s2 += (v[j].x * v[j].x + v[j].y * v[j].y) + (v[j].z * v[j].z + v[j].w * v[j].w); }
        const float rstd = rsqrtf(wave_sum(s2) * (1.0f / DM) + 1e-5f);
        const float* g = p.ln_g + l * DM; const float* bb = p.ln_b + l * DM;
        const int b = m / SEQ; const float* mod = (const float*)(p.ws + WS_MOD) + ((size_t)(l + 1) * NB + b) * 3072;
#pragma unroll
        for (int j = 0; j < 4; ++j) { const int k = j * 256 + lane * 4;
            const f32x4 y = v[j] * rstd * *(const f32x4*)(g + k) + *(const f32x4*)(bb + k);
            *(f32x4*)(row + k) = y;
            if (l + 1 < DEPTH) { const f32x4 h = y * (*(const f32x4*)(mod + 1024 + k) + 1.0f) + *(const f32x4*)(mod + k);
                unsigned long long o = (unsigned long long)pk2(h.x, h.y) | ((unsigned long long)pk2(h.z, h.w) << 32);
                *(unsigned long long*)((bf16_t*)(p.ws + WS_H) + (size_t)m * DM + k) = o; } }
    }
}

__device__ __forceinline__ float rdlane(float v, int l) { return __uint_as_float(__builtin_amdgcn_readlane(__float_as_uint(v), l)); }
__device__ __forceinline__ unsigned fkey(float f) { unsigned u = __float_as_uint(f); if (u == 0x80000000u) u = 0u; return (u & 0x80000000u) ? ~u : (u | 0x80000000u); }

namespace fa {
typedef float f32x16 __attribute__((ext_vector_type(16)));
typedef short s16x4 __attribute__((ext_vector_type(4)));
typedef short v4i16_t __attribute__((ext_vector_type(4)));
typedef float f32x2_t __attribute__((ext_vector_type(2)));
typedef __bf16 bf16x2_t __attribute__((ext_vector_type(2)));
constexpr float THR = 8.0f;
constexpr float MINIT = -1.0e30f;
constexpr int KSLOT = 12288, VSLOT = 8192;
constexpr int L_K = 0, L_V = 2 * KSLOT, L_WS = L_V + 2 * VSLOT, L_OST = L_WS + NWAVES * 256, L_END = L_OST + NWAVES * 4096;
__device__ __forceinline__ int crow(int r, int hi) { return (r & 3) + 8 * (r >> 2) + 4 * hi; }
__device__ __forceinline__ unsigned cvtpk(float lo, float hi) { f32x2_t v = {lo, hi}; bf16x2_t b = __builtin_convertvector(v, bf16x2_t); return __builtin_bit_cast(unsigned, b); }
__device__ __forceinline__ float max32(float v) { auto rr = __builtin_amdgcn_permlane32_swap(__float_as_uint(v), __float_as_uint(v), false, false); return fmaxf(__uint_as_float(rr[0]), __uint_as_float(rr[1])); }
__device__ __forceinline__ float sum32(float v) { auto rr = __builtin_amdgcn_permlane32_swap(__float_as_uint(v), __float_as_uint(v), false, false); return __uint_as_float(rr[0]) + __uint_as_float(rr[1]); }
#define FA_WAIT_BAR() asm volatile("s_waitcnt vmcnt(0) lgkmcnt(0)\n\ts_barrier" ::: "memory")
#define FA_LDS_WAIT() asm volatile("s_waitcnt lgkmcnt(0)" ::: "memory")
__device__ __forceinline__ void glds16(const void* gsrc, LAS unsigned char* dst_uniform) { __builtin_amdgcn_global_load_lds((const unsigned*)gsrc, (LAS unsigned*)dst_uniform, 16, 0, 0); }
__device__ __forceinline__ void glds16_b(const void* gsrc, LAS unsigned char* dst_uniform) { __builtin_amdgcn_global_load_lds((const unsigned*)gsrc, (LAS unsigned*)dst_uniform, 16, 0, 0); }
template <int NCH> __device__ __forceinline__ void dma_k(const bf16_t* kptr, LAS unsigned char* kslot, int wid) {
#pragma unroll
    for (int c0 = 0; c0 < NCH; c0 += 8) { const int c = c0 + wid; if (c < NCH) glds16(kptr + c * 8, kslot + c * 1024); }
}
__device__ __forceinline__ void dma_v(const bf16_t* vptr, LAS unsigned char* vslot, int wid) { glds16(vptr, vslot + wid * 1024); }
template <int NKS> __device__ __forceinline__ void qkt(f32x16& p0, f32x16& p1, const LAS unsigned char* kslot, const bf16x8* qr, int r32, int hi) {
    const LAS unsigned char* kb = kslot + hi * 1024 + r32 * 16;
    bf16x8 kf[2 * NKS];
#pragma unroll
    for (int d0 = 0; d0 < NKS; ++d0) { kf[2 * d0] = *(const LAS bf16x8*)(kb + d0 * 2048); kf[2 * d0 + 1] = *(const LAS bf16x8*)(kb + d0 * 2048 + 512); }
#pragma unroll
    for (int i = 0; i < 2 * NKS; ++i) asm volatile("" : "+v"(kf[i]));
#pragma unroll
    for (int d0 = 0; d0 < NKS; ++d0) {
        p0 = __builtin_amdgcn_mfma_f32_32x32x16_bf16(kf[2 * d0], qr[d0], p0, 0, 0, 0);
        p1 = __builtin_amdgcn_mfma_f32_32x32x16_bf16(kf[2 * d0 + 1], qr[d0], p1, 0, 0, 0);
    }
}
__device__ __forceinline__ s16x4 vtr(const LAS unsigned char* p) { return __builtin_bit_cast(s16x4, __builtin_amdgcn_ds_read_tr16_b64_v4i16((LAS v4i16_t*)p)); }
struct State { float m, l; f32x16 o[2]; f32x16 negm; };
__device__ __forceinline__ void init_state(State& s) { s.m = 0.f; s.l = 0.f;
#pragma unroll
    for (int r = 0; r < 16; ++r) { s.o[0][r] = 0.f; s.o[1][r] = 0.f; s.negm[r] = 0.f; } }
__device__ __forceinline__ float max3f(float a, float b, float c) { float r; asm("v_max3_f32 %0, %1, %2, %3" : "=v"(r) : "v"(a), "v"(b), "v"(c)); return r; }
__device__ __forceinline__ void softmax_pv(State& s, f32x16& p0, f32x16& p1, const LAS unsigned char* vslot, LAS float* wsf, int lane, int r32, int hi) {
    float ra = max3f(p0[0], p0[1], p1[0]), rb = max3f(p0[2], p0[3], p1[1]); ra = max3f(ra, p1[2], p1[3]);
#pragma unroll
    for (int r = 4; r < 16; r += 4) { ra = max3f(ra, p0[r], p0[r + 1]); rb = max3f(rb, p0[r + 2], p0[r + 3]); ra = max3f(ra, p1[r], p1[r + 1]); rb = max3f(rb, p1[r + 2], p1[r + 3]); }
    float rm = max32(fmaxf(ra, rb));
    if (__any(rm > THR)) {
        const float dl = fmaxf(rm, 0.f), f = __builtin_amdgcn_exp2f(-dl);
        s.m += dl; s.l *= f;
#pragma unroll
        for (int r = 0; r < 16; ++r) { p0[r] -= dl; p1[r] -= dl; s.negm[r] = -s.m; }
        FA_LDS_WAIT();
        if (hi == 0) wsf[r32] = f;
        FA_LDS_WAIT();
#pragma unroll
        for (int r = 0; r < 16; ++r) { const float fr = wsf[crow(r, hi)]; s.o[0][r] *= fr; s.o[1][r] *= fr; }
    }
    float sum = 0.f;
#pragma unroll
    for (int r = 0; r < 16; ++r) { p0[r] = __builtin_amdgcn_exp2f(p0[r]); p1[r] = __builtin_amdgcn_exp2f(p1[r]); sum += p0[r] + p1[r]; }
    s.l += sum;
    u32x4 pw[4];
#pragma unroll
    for (int k = 0; k < 2; ++k) {
        pw[k]     = (u32x4){cvtpk(p0[8 * k], p0[8 * k + 1]), cvtpk(p0[8 * k + 2], p0[8 * k + 3]), cvtpk(p0[8 * k + 4], p0[8 * k + 5]), cvtpk(p0[8 * k + 6], p0[8 * k + 7])};
        pw[2 + k] = (u32x4){cvtpk(p1[8 * k], p1[8 * k + 1]), cvtpk(p1[8 * k + 2], p1[8 * k + 3]), cvtpk(p1[8 * k + 4], p1[8 * k + 5]), cvtpk(p1[8 * k + 6], p1[8 * k + 7])};
    }
    const LAS unsigned char* vb = vslot + ((lane >> 4) & 1) * 32 + (lane & 3) * 8 + (4 * hi + ((lane & 15) >> 2)) * 64;
    bf16x8 vf[8];
#pragma unroll
    for (int i = 0; i < 8; ++i) { const s16x4 lo = vtr(vb + (i >> 2) * 4096 + (i & 3) * 1024), hh = vtr(vb + (i >> 2) * 4096 + (i & 3) * 1024 + 512);
        vf[i] = (bf16x8){lo[0], lo[1], lo[2], lo[3], hh[0], hh[1], hh[2], hh[3]}; }
#pragma unroll
    for (int i = 0; i < 8; ++i) asm volatile("" : "+v"(vf[i]));
#pragma unroll
    for (int ks = 0; ks < 4; ++ks) {
        s.o[0] = __builtin_amdgcn_mfma_f32_32x32x16_bf16(__builtin_bit_cast(bf16x8, pw[ks]), vf[ks], s.o[0], 0, 0, 0);
        s.o[1] = __builtin_amdgcn_mfma_f32_32x32x16_bf16(__builtin_bit_cast(bf16x8, pw[ks]), vf[4 + ks], s.o[1], 0, 0, 0);
    }
}
__device__ __forceinline__ void finish(State& s, LAS float* wsf, LAS bf16_t* stg, int r32, int hi, float* lse2) {
    const float lt = sum32(s.l);
    *lse2 = s.m + __builtin_amdgcn_logf(lt);
    FA_LDS_WAIT();
    if (hi == 0) wsf[32 + r32] = __builtin_amdgcn_rcpf(lt);
    FA_LDS_WAIT();
#pragma unroll
    for (int r = 0; r < 16; ++r) { const int orow = crow(r, hi); const float inv = wsf[32 + orow];
        stg[orow * 64 + r32] = (bf16_t)f2bf(s.o[0][r] * inv); stg[orow * 64 + 32 + r32] = (bf16_t)f2bf(s.o[1][r] * inv); }
    FA_LDS_WAIT();
}
}

__device__ __forceinline__ void mla_unit(const Params& p, LAS unsigned char* lds, int b, int h, int qb, int tid) {
    using namespace fa;
    const int lane = tid & 63, r32 = lane & 31, hi = lane >> 5, wid = __builtin_amdgcn_readfirstlane(tid >> 6);
    const int q0 = qb * 256; const size_t rowbase = (size_t)b * SEQ;
    const bf16_t* QA = (const bf16_t*)(p.ws + WS_QA); const bf16_t* KA = (const bf16_t*)(p.ws + WS_KA); const bf16_t* VA = (const bf16_t*)(p.ws + WS_VA);
    LAS float* wsf = (LAS float*)(lds + L_WS) + wid * 64; LAS bf16_t* stg = (LAS bf16_t*)(lds + L_OST) + wid * 2048;
    const bf16_t* kptr = KA + (rowbase + lane) * LD_KA + h * 96;
    const bf16_t* vptr = VA + (rowbase + 16 * (wid & 3) + (lane >> 2)) * LD_VA + h * 64 + (wid >> 2) * 32 + (lane & 3) * 8;
    const int NT = (q0 + 256) / 64;
    FA_WAIT_BAR();
    dma_k<12>(kptr, lds + L_K, wid); dma_v(vptr, lds + L_V, wid);
    bf16x8 qr[6];
    { const bf16_t* qw = QA + (rowbase + q0 + wid * 32 + r32) * LD_QA + h * 96 + hi * 8;
#pragma unroll
      for (int d0 = 0; d0 < 6; ++d0) qr[d0] = *(const bf16x8*)(qw + d0 * 16); }
    State st; init_state(st);
    const int qmin = q0 + wid * 32, q = qmin + r32;
    for (int t = 0; t < NT; ++t) {
        FA_WAIT_BAR();
        const int sl = t & 1;
        if (t + 1 < NT) { dma_k<12>(kptr + (size_t)(t + 1) * 64 * LD_KA, lds + L_K + (sl ^ 1) * KSLOT, wid); dma_v(vptr + (size_t)(t + 1) * 64 * LD_VA, lds + L_V + (sl ^ 1) * VSLOT, wid); }
        if (64 * t <= qmin + 31) {
            f32x16 p0 = st.negm, p1 = st.negm;
            qkt<6>(p0, p1, lds + L_K + sl * KSLOT, qr, r32, hi);
            if (64 * t + 63 > qmin) {
#pragma unroll
                for (int r = 0; r < 16; ++r) { const int kv = 64 * t + crow(r, hi); if (kv > q) p0[r] = -INFINITY; if (kv + 32 > q) p1[r] = -INFINITY; }
            }
            softmax_pv(st, p0, p1, lds + L_V + sl * VSLOT, wsf, lane, r32, hi);
        }
    }
    float lse2; finish(st, wsf, stg, r32, hi, &lse2);
    const bf16_t* PG = (const bf16_t*)(p.ws + WS_PG); bf16_t* Y = (bf16_t*)(p.ws + WS_Y);
#pragma unroll
    for (int i = 0; i < 4; ++i) { const int row = i * 8 + (lane >> 3), ch = lane & 7; const size_t m = rowbase + q0 + wid * 32 + row;
        float o8[8], g8[8]; unpack8(*(const LAS u32x4*)(stg + row * 64 + ch * 8), o8); unpack8(*(const u32x4*)(PG + m * LD_PG + h * 64 + ch * 8), g8);
        u32x4 w; w.x = pk2(o8[0] * silu(g8[0]), o8[1] * silu(g8[1])); w.y = pk2(o8[2] * silu(g8[2]), o8[3] * silu(g8[3]));
        w.z = pk2(o8[4] * silu(g8[4]), o8[5] * silu(g8[5])); w.w = pk2(o8[6] * silu(g8[6]), o8[7] * silu(g8[7]));
        *(u32x4*)(Y + m * DM + h * 64 + ch * 8) = w; }
}
__device__ __forceinline__ void phase_mla(const Params& p, const Ctx& C) {
    const int G = C.G, bx = C.bx, vcu = (G % 8 == 0) ? (bx % 8) * (G / 8) + bx / 8 : bx;
    for (int v = vcu; v < 256; v += G) {
        const int g = v >> 4, i = v & 15;
#pragma unroll 1
        for (int j = 0; j < 3; ++j) {
            const int bh = 3 * g + j, qb = (j == 0) ? i : (j == 1) ? ((i + 8) & 15) : (i < 8 ? 15 - 2 * i : 30 - 2 * i);
            mla_unit(p, C.lds, bh / 6, bh % 6, qb, C.tid);
        }
    }
    __syncthreads();
}

__device__ __forceinline__ void sparse_unit(const Params& p, LAS unsigned char* lds, int b, int h, int qb, int tid) {
    using namespace fa;
    const int lane = tid & 63, r32 = lane & 31, hi = lane >> 5, wid = __builtin_amdgcn_readfirstlane(tid >> 6);
    const int q0 = qb * 256; const size_t rowbase = (size_t)b * SEQ;
    const bf16_t* PC = (const bf16_t*)(p.ws + WS_PC);
    LAS float* wsf = (LAS float*)(lds + L_WS) + wid * 64; LAS bf16_t* stg = (LAS bf16_t*)(lds + L_OST) + wid * 2048;
    const bf16_t* kptr = PC + (rowbase + lane) * LD_PC + 256 + h * 64;
    const bf16_t* vptr = PC + (rowbase + 16 * (wid & 3) + (lane >> 2)) * LD_PC + 512 + h * 64 + (wid >> 2) * 32 + (lane & 3) * 8;
    const int NT = (q0 + 256) / 64;
    FA_WAIT_BAR();
    dma_k<8>(kptr, lds + L_K, wid); dma_v(vptr, lds + L_V, wid);
    const int qmin = q0 + wid * 32, q = qmin + r32;
    bf16x8 qr[4];
    { const bf16_t* qw = PC + (rowbase + q) * LD_PC + h * 64 + hi * 8;
#pragma unroll
      for (int d0 = 0; d0 < 4; ++d0) qr[d0] = *(const bf16x8*)(qw + d0 * 16); }
    const u64* mrow = (const u64*)(p.ws + WS_MASK) + (rowbase + q) * 64;
    const float sl2 = exp2f(-0.8f * (float)(7 + h)) * LOG2E;
    State st; init_state(st);
    const int nact = (qmin + 31) / 64 + 1;
    u64 wcur = mrow[0];
    for (int t = 0; t < NT; ++t) {
        FA_WAIT_BAR();
        const int sl = t & 1;
        if (t + 1 < NT) { dma_k<8>(kptr + (size_t)(t + 1) * 64 * LD_PC, lds + L_K + (sl ^ 1) * KSLOT, wid); dma_v(vptr + (size_t)(t + 1) * 64 * LD_PC, lds + L_V + (sl ^ 1) * VSLOT, wid); }
        if (t < nact) {
            const u64 wnext = (t + 1 < nact) ? mrow[t + 1] : 0ull;
            if (__any(wcur != 0ull)) {
                const unsigned wl = (unsigned)wcur >> (4 * hi), wh = (unsigned)(wcur >> 32) >> (4 * hi);
                const float base = sl2 * (float)(64 * t + 4 * hi - q) - st.m;
                f32x16 p0, p1;
#pragma unroll
                for (int r = 0; r < 16; ++r) { const int cr = (r & 3) + 8 * (r >> 2);
                    p0[r] = (wl & (1u << cr)) ? fmaf(sl2, (float)cr, base) : -INFINITY;
                    p1[r] = (wh & (1u << cr)) ? fmaf(sl2, (float)(cr + 32), base) : -INFINITY; }
                qkt<4>(p0, p1, lds + L_K + sl * KSLOT, qr, r32, hi);
                softmax_pv(st, p0, p1, lds + L_V + sl * VSLOT, wsf, lane, r32, hi);
            }
            wcur = wnext;
        }
    }
    float lse2; finish(st, wsf, stg, r32, hi, &lse2);
    const bf16_t* PG = (const bf16_t*)(p.ws + WS_PG); bf16_t* Y = (bf16_t*)(p.ws + WS_Y);
#pragma unroll
    for (int i = 0; i < 4; ++i) { const int row = i * 8 + (lane >> 3), ch = lane & 7; const size_t m = rowbase + q0 + wid * 32 + row;
        float o8[8], g8[8]; unpack8(*(const LAS u32x4*)(stg + row * 64 + ch * 8), o8); unpack8(*(const u32x4*)(PG + m * LD_PG + 768 + h * 64 + ch * 8), g8);
        u32x4 w; w.x = pk2(o8[0] * silu(g8[0]), o8[1] * silu(g8[1])); w.y = pk2(o8[2] * silu(g8[2]), o8[3] * silu(g8[3]));
        w.z = pk2(o8[4] * silu(g8[4]), o8[5] * silu(g8[5])); w.w = pk2(o8[6] * silu(g8[6]), o8[7] * silu(g8[7]));
        *(u32x4*)(Y + m * DM + 768 + h * 64 + ch * 8) = w; }
}
__device__ __forceinline__ void phase_sparse(const Params& p, const Ctx& C) {
    const int G = C.G, bx = C.bx, vcu = (G % 8 == 0) ? (bx % 8) * (G / 8) + bx / 8 : bx;
    for (int v = vcu; v < 256; v += G) {
        const int bh = v >> 3, i = v & 7;
        sparse_unit(p, C.lds, bh >> 2, bh & 3, i, C.tid);
        sparse_unit(p, C.lds, bh >> 2, bh & 3, 15 - i, C.tid);
    }
    __syncthreads();
}

constexpr unsigned NEGKEY = 0x007FFFFFu;
constexpr int IX_SC = 0, IX_HIST = 131072, IX_CAND = IX_HIST + NWAVES * 2048, IX_END = IX_CAND + NWAVES * 512;
template <int R> __device__ __forceinline__ void put_word(unsigned& mlo, unsigned& mhi, u64 word) {
    const unsigned wl = (unsigned)word, wh = (unsigned)(word >> 32);
    asm("s_nop 3\n\tv_writelane_b32 %0, %2, %4\n\tv_writelane_b32 %1, %3, %4" : "+v"(mlo), "+v"(mhi) : "s"(wl), "s"(wh), "i"(R));
}
template <int R> struct OutWordsK {
    static __device__ __forceinline__ void run(const unsigned (&u)[64], unsigned thr, int need, int& run_, u64 ltmask, unsigned& mlo, unsigned& mhi) {
        const bool gt = u[R] > thr, eq = u[R] == thr; const u64 beq = __ballot(eq); const int pos = run_ + __popcll(beq & ltmask);
        const u64 word = __ballot(gt || (eq && pos < need)); run_ += __popcll(beq); put_word<R>(mlo, mhi, word);
        OutWordsK<R + 1>::run(u, thr, need, run_, ltmask, mlo, mhi);
    }
};
template <> struct OutWordsK<64> { static __device__ __forceinline__ void run(const unsigned (&)[64], unsigned, int, int&, u64, unsigned&, unsigned&) {} };
__device__ __forceinline__ u64 select256(const unsigned (&u)[64], int lane) {
    unsigned thr = 0u; int cge = 0;
    for (int bit = 31; bit >= 0; --bit) {
        const unsigned cand = thr | (1u << bit); int c = 0;
#pragma unroll
        for (int r = 0; r < 64; ++r) c += __popcll(__ballot(u[r] >= cand));
        if (c >= 256) { thr = cand; cge = c; if (c == 256) break; }
    }
    unsigned mlo = 0u, mhi = 0u;
    int cgt = 0;
#pragma unroll
    for (int r = 0; r < 64; ++r) cgt += __popcll(__ballot(u[r] > thr));
    const int need = 256 - cgt; int run = 0;
    const u64 ltmask = (lane == 0) ? 0ull : (~0ull >> (64 - lane));
    OutWordsK<0>::run(u, thr, need, run, ltmask, mlo, mhi);
    (void)cge;
    return (u64)mlo | ((u64)mhi << 32);
}
__device__ __forceinline__ int dpp_scan_incl(int v) {
    v += __builtin_amdgcn_update_dpp(0, v, 0x111, 0xf, 0xf, false);
    v += __builtin_amdgcn_update_dpp(0, v, 0x112, 0xf, 0xf, false);
    v += __builtin_amdgcn_update_dpp(0, v, 0x114, 0xf, 0xf, false);
    v += __builtin_amdgcn_update_dpp(0, v, 0x118, 0xf, 0xf, false);
    v += __builtin_amdgcn_update_dpp(0, v, 0x142, 0xa, 0xf, false);
    v += __builtin_amdgcn_update_dpp(0, v, 0x143, 0xc, 0xf, false);
    return v;
}
__device__ __forceinline__ unsigned cvt_u32(float x) { unsigned r; asm("v_cvt_u32_f32 %0, %1" : "=v"(r) : "v"(x)); return r; }
__device__ __forceinline__ float vmax_abs(float a, float b) { float r; asm("v_max_f32 %0, %1, |%2|" : "=v"(r) : "v"(a), "v"(b)); return r; }
template <int NR, bool TIE> struct OutWords2;
template <int NR> __device__ __forceinline__ bool select_row_fast(const LAS float* row, int lane, LAS unsigned* hist, LAS float* cs, LAS int* ci, u64& out) {
    float s[NR];
#pragma unroll
    for (int r = 0; r < NR; ++r) s[r] = row[64 * r + lane];
    float R = 0.f;
#pragma unroll
    for (int r = 0; r < NR; ++r) R = vmax_abs(R, s[r]);
    R = wave_max(R); R = fmaxf(R, 1e-30f);
    const float c4 = 2047.9f / (2.0f * R), o4 = R * c4;
#pragma unroll
    for (int i = 0; i < 8; ++i) hist[i * 64 + lane] = 0u;
#pragma unroll
    for (int r = 0; r < NR; ++r) { const unsigned a = cvt_u32(fmaf(s[r], c4, o4)) & 0x7fcu; __hip_atomic_fetch_add((LAS unsigned*)((LAS unsigned char*)hist + a), 1u, __ATOMIC_RELAXED, __HIP_MEMORY_SCOPE_WORKGROUP); }
    asm volatile("s_waitcnt lgkmcnt(0)" ::: "memory");
    const u32x4 h0 = *(const LAS u32x4*)(hist + 504 - 8 * lane), h1 = *(const LAS u32x4*)(hist + 508 - 8 * lane);
    const int cnt8 = (int)((h0.x + h0.y) + (h0.z + h0.w) + (h1.x + h1.y) + (h1.z + h1.w));
    const int P = dpp_scan_incl(cnt8);
    const u64 bm = __ballot(P >= 256);
    const int L = __builtin_ctzll(bm);
    int B4, cab;
    { int cum = P - cnt8, bsel = -1, csel = 0;
#define IX_STEP(hv, j) { const int c_ = (int)(hv); if (bsel < 0 && cum + c_ >= 256) { bsel = 511 - 8 * lane - (j); csel = cum; } cum += c_; }
      IX_STEP(h1.w, 0) IX_STEP(h1.z, 1) IX_STEP(h1.y, 2) IX_STEP(h1.x, 3) IX_STEP(h0.w, 4) IX_STEP(h0.z, 5) IX_STEP(h0.y, 6) IX_STEP(h0.x, 7)
#undef IX_STEP
      B4 = __builtin_amdgcn_readlane(bsel, L) * 4; cab = __builtin_amdgcn_readlane(csel, L); }
    int nc = 0; const u64 ltmask = (lane == 0) ? 0ull : (~0ull >> (64 - lane));
#pragma unroll
    for (int r = 0; r < NR; ++r) {
        const bool match = (int)(cvt_u32(fmaf(s[r], c4, o4)) & 0x7fcu) == B4; const u64 m = __ballot(match);
        if (m) { const int pos = nc + __popcll(m & ltmask); int l2 = lane; asm volatile("" : "+v"(l2)); if (match && pos < 64) { cs[pos] = s[r]; ci[pos] = 64 * r + l2; } nc += __popcll(m); }
    }
    if (B4 == 0 || nc > 64) return false;
    asm volatile("s_waitcnt lgkmcnt(0)" ::: "memory");
    const bool act = lane < nc; const float c = act ? cs[lane] : 0.f; const int id = act ? ci[lane] : 0;
    const int kk = 256 - cab;
    int rank = 0;
    for (int j = 0; j < nc; ++j) { const float cj = rdlane(c, j); const int ij = __builtin_amdgcn_readlane(id, j); rank += (cj > c || (cj == c && ij < id)) ? 1 : 0; }
    const u64 tm = __ballot(act && rank == kk - 1);
    const int tl = __builtin_ctzll(tm);
    const float thr = rdlane(c, tl); const int thri = __builtin_amdgcn_readlane(id, tl);
    const bool tie = __popcll(__ballot(act && c == thr)) > 1;
    unsigned mlo = 0u, mhi = 0u;
    if (!tie) OutWords2<NR, false>::template run<0>(s, thr, thri, lane, mlo, mhi); else OutWords2<NR, true>::template run<0>(s, thr, thri, lane, mlo, mhi);
    out = (u64)mlo | ((u64)mhi << 32);
    return true;
}
template <int NR, bool TIE> struct OutWords2 {
    template <int R> static __device__ __forceinline__ void run(const float (&s)[NR], float thr, int thri, int lane, unsigned& mlo, unsigned& mhi) {
        if constexpr (R < NR) {
            int lim = thri - 64 * R; asm("" : "+s"(lim));
            const u64 word = TIE ? __ballot(s[R] > thr || (s[R] == thr && lane <= lim)) : __ballot(s[R] >= thr); put_word<R>(mlo, mhi, word);
            run<R + 1>(s, thr, thri, lane, mlo, mhi);
        }
    }
};
#ifndef IDX_REP_SC
#define IDX_REP_SC 1
#endif
#ifndef IDX_REP_SEL
#define IDX_REP_SEL 1
#endif
template <int REP_SC, int REP_SEL> __device__ __forceinline__ void idx_unit(const Params& p, LAS unsigned char* lds, int b, int g, int tid) {
    typedef float f32x16 __attribute__((ext_vector_type(16)));
    const int lane = tid & 63, r32 = lane & 31, hi = lane >> 5, wid = __builtin_amdgcn_readfirstlane(tid >> 6);
    const int t0 = g * 8; const size_t rowbase = (size_t)b * SEQ;
    u64* mask = (u64*)(p.ws + WS_MASK);
    const int t = t0 + wid;
    if (t0 < 256) {
        const int lo = lane * 64; u64 word = 0ull;
        if (t >= lo + 63) word = ~0ull; else if (t >= lo) word = (~0ull) >> (63 - (t - lo));
        mask[(rowbase + t) * 64 + lane] = word; return;
    }
    const bf16_t* PI = (const bf16_t*)(p.ws + WS_PI);
    LAS float* sc = (LAS float*)(lds + IX_SC);
    const int nkt_all = ((t0 + 8 + 63) >> 6) * 2;
#pragma unroll 1
    for (int rep = 0; rep < REP_SC; ++rep) {
    bf16x8 aq[2][4];
    { const int ql = 2 * ((r32 >> 2) & 1) + (r32 >> 4), hd = 4 * ((r32 >> 3) & 1) + (r32 & 3);
#pragma unroll
      for (int rt = 0; rt < 2; ++rt) { const bf16_t* qp = PI + (rowbase + t0 + 4 * rt + ql) * LD_PI + hd * 64 + hi * 8;
#pragma unroll
          for (int ks = 0; ks < 4; ++ks) aq[rt][ks] = *(const bf16x8*)(qp + ks * 16); } }
    float wq[2][16];
    { u32x4 wr4[4];
#pragma unroll
      for (int i = 0; i < 4; ++i) wr4[i] = *(const u32x4*)((const bf16_t*)(p.ws + WS_WI2) + (rowbase + t0 + 4 * (i >> 1) + 2 * hi + (i & 1)) * 8);
      asm volatile("" : "+v"(wr4[0]), "+v"(wr4[1]), "+v"(wr4[2]), "+v"(wr4[3]));
#pragma unroll
      for (int i = 0; i < 4; ++i) unpack8(wr4[i], &wq[i >> 1][8 * (i & 1)]); }
    const int nkt = nkt_all;
    const bf16_t* kp = (const bf16_t*)(p.ws + WS_KI2) + (size_t)b * 128 * 2048 + lane * 8;
    bf16x8 ka[3][4], kc[3][4];
#define IX_LOAD(dst, kt0) do { _Pragma("unroll") for (int j4 = 0; j4 < 3; ++j4) { const int kt_ = (kt0) + 8 * j4; const int ktc = kt_ < nkt ? kt_ : nkt - 1; \
        _Pragma("unroll") for (int ks = 0; ks < 4; ++ks) dst[j4][ks] = *(const bf16x8*)(kp + (size_t)ktc * 2048 + ks * 512); } } while (0)
#define IX_EPI(acc_, rt_, ktj_) do { float s0 = 0.f, s1 = 0.f; \
            _Pragma("unroll") for (int r = 0; r < 8; ++r) { s0 = fmaf(wq[rt_][r], acc_[r] + __builtin_fabsf(acc_[r]), s0); s1 = fmaf(wq[rt_][8 + r], acc_[8 + r] + __builtin_fabsf(acc_[8 + r]), s1); } \
            const int key = (ktj_) * 32 + r32, qa = t0 + 4 * (rt_) + 2 * hi; const float qnan = __uint_as_float(0x7fc00000u); \
            sc[(4 * (rt_) + 2 * hi) * 4096 + key] = (key <= qa) ? s0 : qnan; sc[(4 * (rt_) + 2 * hi + 1) * 4096 + key] = (key <= qa + 1) ? s1 : qnan; } while (0)
#define IX_COMPUTE(src, kt0) do { _Pragma("unroll") for (int j4 = 0; j4 < 3; ++j4) { const int ktj = (kt0) + 8 * j4; \
        if (ktj < nkt) { f32x16 acc0, acc1; _Pragma("unroll") for (int r = 0; r < 16; ++r) { acc0[r] = 0.f; acc1[r] = 0.f; } \
            _Pragma("unroll") for (int ks = 0; ks < 4; ++ks) acc0 = __builtin_amdgcn_mfma_f32_32x32x16_bf16(aq[0][ks], src[j4][ks], acc0, 0, 0, 0); \
            _Pragma("unroll") for (int ks = 0; ks < 4; ++ks) acc1 = __builtin_amdgcn_mfma_f32_32x32x16_bf16(aq[1][ks], src[j4][ks], acc1, 0, 0, 0); \
            IX_EPI(acc0, 0, ktj); IX_EPI(acc1, 1, ktj); } } } while (0)
    IX_LOAD(ka, wid);
    for (int kt = wid; kt < nkt; kt += 48) {
        IX_LOAD(kc, kt + 24);
        IX_COMPUTE(ka, kt);
        IX_LOAD(ka, kt + 48);
        IX_COMPUTE(kc, kt + 24);
    }
#undef IX_COMPUTE
#undef IX_EPI
#undef IX_LOAD
    }
    const int NR = 16 * ((t0 + 8 + 1023) >> 10);
    { const float qnan = __uint_as_float(0x7fc00000u);
      for (int k = nkt_all * 32 + lane; k < NR * 64; k += 64) sc[wid * 4096 + k] = qnan; }
    __syncthreads();
#pragma unroll 1
    for (int rep = 0; rep < REP_SEL; ++rep) {
        LAS unsigned* hist = (LAS unsigned*)(lds + IX_HIST) + wid * 512; LAS float* cs = (LAS float*)(lds + IX_CAND) + wid * 128; LAS int* ci = (LAS int*)(lds + IX_CAND) + wid * 128 + 64;
        const LAS float* row = sc + wid * 4096; u64 word = 0ull; bool ok;
        if (NR == 16) ok = select_row_fast<16>(row, lane, hist, cs, ci, word);
        else if (NR == 32) ok = select_row_fast<32>(row, lane, hist, cs, ci, word);
        else if (NR == 48) ok = select_row_fast<48>(row, lane, hist, cs, ci, word);
        else ok = select_row_fast<64>(row, lane, hist, cs, ci, word);
        if (!ok) {
            unsigned u[64];
#pragma unroll
            for (int r = 0; r < 64; ++r) { int lim = t - 64 * r; asm("" : "+s"(lim)); u[r] = (lane <= lim) ? fkey(row[64 * r + lane]) : NEGKEY; }
            word = select256(u, lane);
        }
        mask[(rowbase + t) * 64 + lane] = word;
    }
    __syncthreads();
}
__device__ __forceinline__ void phase_idx(const Params& p, const Ctx& C) {
    const int G = C.G, bx = C.bx, vcu = (G % 8 == 0) ? (bx % 8) * (G / 8) + bx / 8 : bx;
    for (int v = vcu; v < 256; v += G) {
        const int b = v >> 5, k = v & 31;
#pragma unroll 1
        for (int j = 0; j < 16; ++j) idx_unit<IDX_REP_SC, IDX_REP_SEL>(p, C.lds, b, ((j & 1) ? 31 - k : k) + 32 * j, C.tid);
    }
    __syncthreads();
}

constexpr size_t WS_LSE = WS_PART + (size_t)3 * T * 384 * 2;
constexpr int DL_K = 0, DL_V = 6 * 8192, DL_WS = 12 * 8192, DL_OST = DL_WS + NWAVES * 256, DL_END = DL_OST + NWAVES * 4096;
struct DilU { int b, h, pi, d, res, j; };
__device__ __forceinline__ DilU dil_decode(int uid) { DilU u; const int k16 = uid & 15; u.pi = (uid >> 4) % 3; const int bh = uid / 48; u.b = bh / 6; u.h = bh % 6;
    u.d = (u.pi == 0) ? 1 : (u.pi == 1) ? 4 : 16; const int nblk = 16 / u.d; u.res = k16 / nblk; u.j = k16 % nblk; return u; }
__device__ __forceinline__ void dil_issue(const Params& p, LAS unsigned char* lds, const DilU& U, int lane, int wid, bf16x8 (&qr)[4]) {
    using namespace fa;
    const size_t hb = (size_t)(U.b * 6 + U.h) * SEQ;
    const bf16_t* QD = (const bf16_t*)(p.ws + WS_QD); const bf16_t* KD = (const bf16_t*)(p.ws + WS_KD); const bf16_t* VD = (const bf16_t*)(p.ws + WS_VD);
    const int base = 256 * U.j - 128, hi = lane >> 5, r32 = lane & 31;
#pragma unroll
    for (int u = 0; u < 6; ++u) {
        int ik = base + 64 * u + lane; ik = ik < 0 ? 0 : ik;
        glds16_b(KD + (hb + perm16((unsigned)(U.res + U.d * ik))) * 64 + wid * 8, lds + DL_K + u * 8192 + wid * 1024);
        int iv = base + 64 * u + 16 * (wid & 3) + (lane >> 2); iv = iv < 0 ? 0 : iv;
        glds16_b(VD + (hb + perm16((unsigned)(U.res + U.d * iv))) * 64 + (wid >> 2) * 32 + (lane & 3) * 8, lds + DL_V + u * 8192 + wid * 1024);
    }
    const int iq = 256 * U.j + 32 * wid + r32; const bf16_t* qw = QD + (hb + perm16((unsigned)(U.res + U.d * iq))) * 64 + hi * 8;
#pragma unroll
    for (int d0 = 0; d0 < 4; ++d0) qr[d0] = *(const bf16x8*)(qw + d0 * 16);
}
__device__ __forceinline__ void phase_dil(const Params& p, const Ctx& C) {
    using namespace fa;
    const int G = C.G, bx = C.bx, vcu = (G % 8 == 0) ? (bx % 8) * (G / 8) + bx / 8 : bx;
    LAS unsigned char* lds = C.lds; const int tid = C.tid, lane = tid & 63, r32 = lane & 31, hi = lane >> 5, wid = C.wave;
    LAS float* wsf = (LAS float*)(lds + DL_WS) + wid * 64; LAS bf16_t* stg = (LAS bf16_t*)(lds + DL_OST) + wid * 2048;
    const int uid0 = vcu * 9;
    bf16x8 qr[4], qn[4];
    FA_WAIT_BAR();
    dil_issue(p, lds, dil_decode(uid0), lane, wid, qr);
    float lse_prev = 0.f;
#define DIL_STORE(UU, lse_) do { const DilU& U_ = (UU); const size_t rb_ = (size_t)U_.b * SEQ; \
        bf16_t* PART = (bf16_t*)(p.ws + WS_PART) + (size_t)U_.pi * T * 384; float* LSE = (float*)(p.ws + WS_LSE) + (size_t)U_.pi * T * 6; \
        if (hi == 0) LSE[(rb_ + U_.res + U_.d * (256 * U_.j + 32 * wid + r32)) * 6 + U_.h] = (lse_); \
        _Pragma("unroll") for (int i = 0; i < 4; ++i) { const int row = i * 8 + (lane >> 3), ch = lane & 7; const size_t m = rb_ + U_.res + U_.d * (256 * U_.j + 32 * wid + row); \
            *(u32x4*)(PART + m * 384 + U_.h * 64 + ch * 8) = *(const LAS u32x4*)(stg + row * 64 + ch * 8); } } while (0)
#pragma unroll 1
    for (int k = 0; k < 9; ++k) {
        const DilU U = dil_decode(uid0 + k);
        const int base = 256 * U.j - 128, d = U.d, h = U.h;
        const int iq = 256 * U.j + 32 * wid + r32;
        const float sld = exp2f(-0.8f * (float)(h + 1)) * LOG2E * (float)d;
        const unsigned lim = (unsigned)(iq < 128 ? iq : 128);
        State st; init_state(st);
        FA_WAIT_BAR();
        if (k > 0) DIL_STORE(dil_decode(uid0 + k - 1), lse_prev);
#pragma unroll 1
        for (int uu = 0; uu < 3; ++uu) {
            const int u = (wid >> 1) + uu;
            if (base + 64 * u + 63 < 0) continue;
            const int e0 = iq - base - 64 * u - 4 * hi;
            f32x16 p0, p1;
#pragma unroll
            for (int r = 0; r < 16; ++r) { const int cr = (r & 3) + 8 * (r >> 2); const int d0 = e0 - cr, d1 = e0 - cr - 32;
                p0[r] = ((unsigned)d0 <= lim) ? fmaf(-sld, (float)d0, -st.m) : -INFINITY;
                p1[r] = ((unsigned)d1 <= lim) ? fmaf(-sld, (float)d1, -st.m) : -INFINITY; }
            qkt<4>(p0, p1, lds + DL_K + u * 8192, qr, r32, hi);
            softmax_pv(st, p0, p1, lds + DL_V + u * 8192, wsf, lane, r32, hi);
        }
        asm volatile("s_waitcnt lgkmcnt(0)\n\ts_barrier" ::: "memory");
        if (k + 1 < 9) dil_issue(p, lds, dil_decode(uid0 + k + 1), lane, wid, qn);
        finish(st, wsf, stg, r32, hi, &lse_prev);
#pragma unroll
        for (int d0 = 0; d0 < 4; ++d0) qr[d0] = qn[d0];
    }
    DIL_STORE(dil_decode(uid0 + 8), lse_prev);
#undef DIL_STORE
    __syncthreads();
}
__device__ __forceinline__ void phase_dilcombine(const Params& p, const Ctx& C) {
    const bf16_t* PART = (const bf16_t*)(p.ws + WS_PART); const float* LSE = (const float*)(p.ws + WS_LSE);
    const bf16_t* PG = (const bf16_t*)(p.ws + WS_PG); bf16_t* Y = (bf16_t*)(p.ws + WS_Y);
    for (int e = C.bx * NTHREADS + C.tid; e < T * 48; e += C.G * NTHREADS) {
        const int m = e / 48, c = e % 48, h = c >> 3;
        const float l0 = LSE[(size_t)m * 6 + h], l1 = LSE[((size_t)T + m) * 6 + h], l2 = LSE[((size_t)2 * T + m) * 6 + h];
        const float mx = fmaxf(l0, fmaxf(l1, l2));
        float w0 = exp2f(l0 - mx), w1 = exp2f(l1 - mx), w2 = exp2f(l2 - mx); const float inv = 1.0f / (w0 + w1 + w2); w0 *= inv; w1 *= inv; w2 *= inv;
        float a[8], bb[8], cc[8], g[8];
        unpack8(*(const u32x4*)(PART + (size_t)m * 384 + c * 8), a); unpack8(*(const u32x4*)(PART + ((size_t)T + m) * 384 + c * 8), bb); unpack8(*(const u32x4*)(PART + ((size_t)2 * T + m) * 384 + c * 8), cc);
        unpack8(*(const u32x4*)(PG + (size_t)m * LD_PG + 384 + c * 8), g);
        float y[8];
#pragma unroll
        for (int i = 0; i < 8; ++i) y[i] = (w0 * a[i] + w1 * bb[i] + w2 * cc[i]) * silu(g[i]);
        u32x4 o; o.x = pk2(y[0], y[1]); o.y = pk2(y[2], y[3]); o.z = pk2(y[4], y[5]); o.w = pk2(y[6], y[7]);
        *(u32x4*)(Y + (size_t)m * DM + 384 + c * 8) = o;
    }
}

typedef unsigned v4u_unused;
#define XB_TMO      128
#define XB_XCNT(j)  (256  + 64 * (j))
#define XB_XSUB(j)  (1280 + 64 * (j))
#define XB_XGEN(j)  (2304 + 64 * (j))
#define XB_TOP      3328
#define XB_TOPGEN   3392
#define XCD_BAR_WORDS 3456
#define XB_SPIN_CAP (1u << 18)

__device__ __forceinline__ unsigned xb_ld(unsigned* p)              { return __hip_atomic_load(p, __ATOMIC_RELAXED, __HIP_MEMORY_SCOPE_AGENT); }
__device__ __forceinline__ unsigned xb_add(unsigned* p, unsigned v) { return __hip_atomic_fetch_add(p, v, __ATOMIC_RELAXED, __HIP_MEMORY_SCOPE_AGENT); }
__device__ __forceinline__ unsigned xb_xcc_id() { return (unsigned)__builtin_amdgcn_s_getreg((3 << 11) | 20) & 0xFu; }
#define XB_SPIN(cond, bar) do { unsigned _sp = 0; while (cond) { __builtin_amdgcn_s_sleep(1); \
    if ((++_sp & 255u) == 0u) { if (xb_ld(&(bar)[XB_TMO])) break; if (_sp > XB_SPIN_CAP) { atomicAdd(&(bar)[XB_TMO], 1u); break; } } } } while (0)

struct XcdBarrier {
    unsigned* bar; unsigned x;
    volatile LAS unsigned* st;
};

__device__ __forceinline__ XcdBarrier xcd_barrier_post(unsigned* bar, volatile LAS unsigned* st, int tid) {
    XcdBarrier b; b.bar = bar; b.x = xb_xcc_id(); b.st = st;
    if (tid == 0) (void)xb_add(&bar[XB_XCNT(b.x)], 1u);
    return b;
}
__device__ __forceinline__ void xcd_barrier_complete(unsigned* bar, unsigned x, unsigned& nloc, unsigned& nx) {
    const unsigned G = gridDim.x * gridDim.y * gridDim.z;
    unsigned sum, cnt, mine, sp = 0u;
    for (;;) {
        sum = 0u; cnt = 0u; mine = 0u;
#pragma unroll
        for (unsigned j = 0; j < 16; ++j) { const unsigned c = xb_ld(&bar[XB_XCNT(j)]); sum += c; cnt += (c > 0u) ? 1u : 0u; mine = (j == x) ? c : mine; }
        if (sum == G) break;
        __builtin_amdgcn_s_sleep(1);
        if ((++sp & 255u) == 0u) { if (xb_ld(&bar[XB_TMO])) break; if (sp > XB_SPIN_CAP) { atomicAdd(&bar[XB_TMO], 1u); break; } }
    }
    nloc = mine > 0u ? mine : 1u; nx = cnt > 0u ? cnt : 1u;
}

__device__ __forceinline__ void xcd_barrier(const XcdBarrier& b, int tid) {
    asm volatile("s_waitcnt vmcnt(0)" ::: "memory");
    __syncthreads();
    if (tid == 0) {
        unsigned* bar = b.bar;
        __builtin_amdgcn_s_waitcnt(0);
        unsigned nloc = b.st[0], nx = b.st[1];
        if (nloc == 0u) { xcd_barrier_complete(bar, b.x, nloc, nx); b.st[0] = nloc; b.st[1] = nx; }
        const unsigned old = xb_add(&bar[XB_XSUB(b.x)], 1u);
        const unsigned gen = old / nloc;
        if (old + 1u == (gen + 1u) * nloc) {
            __builtin_amdgcn_fence(__ATOMIC_RELEASE, "agent");
            asm volatile("s_waitcnt vmcnt(0)" ::: "memory");
            const unsigned og = xb_add(&bar[XB_TOP], 1u);
            const unsigned tg = og / nx;
            if (og + 1u == (tg + 1u) * nx) xb_add(&bar[XB_TOPGEN], 1u);
            else XB_SPIN(xb_ld(&bar[XB_TOPGEN]) == tg, bar);
            __builtin_amdgcn_fence(__ATOMIC_ACQUIRE, "agent");
            xb_add(&bar[XB_XGEN(b.x)], 1u);
            asm volatile("s_waitcnt vmcnt(0)" ::: "memory");
        } else {
            XB_SPIN(xb_ld(&bar[XB_XGEN(b.x)]) == gen, bar);
            __builtin_amdgcn_fence(__ATOMIC_ACQUIRE, "agent");
            asm volatile("s_waitcnt vmcnt(0)" ::: "memory");
        }
    }
    __syncthreads();
}


constexpr int CW_BAR = 4096;
constexpr int LDS_ST_OFF = LDS_BYTES - 64;
__global__ void __launch_bounds__(NTHREADS, 2) mega(Params p) {
    extern __shared__ __attribute__((aligned(16))) unsigned char lds_raw[];
    cg::grid_group grid = cg::this_grid();
    LAS unsigned char* lds = (LAS unsigned char*)lds_raw;
    unsigned* barw = (unsigned*)(p.ws + WS_CTL) + CW_BAR;
    const int wave_s = __builtin_amdgcn_readfirstlane((int)threadIdx.x >> 6);
    { const int tid0 = threadIdx.x;
      if (blockIdx.x == 0) for (int i = tid0; i < XCD_BAR_WORDS; i += NTHREADS) __hip_atomic_store(barw + i, 0u, __ATOMIC_RELAXED, __HIP_MEMORY_SCOPE_AGENT);
      if (tid0 < 16) ((LAS unsigned*)(lds + LDS_ST_OFF))[tid0] = 0u; }
    __syncthreads();
#define CX fresh_ctx(lds, wave_s)
#define PX fresh_params(p)
    phase_prologue(PX, CX);
    __syncthreads(); grid.sync();
    (void)xcd_barrier_post(barw, (volatile LAS unsigned*)(lds + LDS_ST_OFF), CX.tid);
#define GRID_SYNC() do { XcdBarrier xb_; { size_t z_ = 0; asm volatile("" : "+s"(z_)); xb_.bar = (unsigned*)(p.ws + WS_CTL + z_) + CW_BAR; } xb_.x = xb_xcc_id(); xb_.st = (volatile LAS unsigned*)(lds + LDS_ST_OFF); xcd_barrier(xb_, CX.tid); } while (0)
    phase_makeh(PX, CX); GRID_SYNC();
    for (int l = 0; l < DEPTH; ++l) {
        phase_gemm<0>(PX, CX, l); GRID_SYNC();
        phase_rs(PX, CX); phase_gemm<1>(PX, CX, l); phase_gemm<2>(PX, CX, l); __syncthreads();
        phase_idx(PX, CX); phase_dil(PX, CX); GRID_SYNC();
        phase_dilcombine(PX, CX); phase_mla(PX, CX); phase_sparse(PX, CX); GRID_SYNC();
        phase_gemm<3>(PX, CX, l); GRID_SYNC();
        phase_ln(PX, CX, l); if (l + 1 < DEPTH) GRID_SYNC();
    }
}

extern "C" void kernel_launch(void* const* d_in, const int* in_sizes, int n_in, void* d_out, int out_size, void* d_ws, size_t ws_size, hipStream_t stream) {
    static int grid = 0;
    if (grid == 0) {
        if (n_in != 13 || in_sizes[0] != T * DM || out_size != T * DM || ws_size < WS_END) { fprintf(stderr, "kernel_launch: unexpected shapes (n_in %d, in0 %d, out %d, ws %zu)\n", n_in, n_in > 0 ? in_sizes[0] : -1, out_size, ws_size); grid = -1; return; }
        int dev = 0, cus = 0, per_cu = 0;
        if (hipGetDevice(&dev) != hipSuccess || hipDeviceGetAttribute(&cus, hipDeviceAttributeMultiprocessorCount, dev) != hipSuccess) { fprintf(stderr, "kernel_launch: device query failed\n"); grid = -1; return; }
        if (hipFuncSetAttribute((const void*)mega, hipFuncAttributeMaxDynamicSharedMemorySize, LDS_BYTES) != hipSuccess) { fprintf(stderr, "kernel_launch: hipFuncSetAttribute failed\n"); grid = -1; return; }
        if (hipOccupancyMaxActiveBlocksPerMultiprocessor(&per_cu, (const void*)mega, NTHREADS, LDS_BYTES) != hipSuccess || per_cu < 1) { fprintf(stderr, "kernel_launch: occupancy query says %d blocks/CU\n", per_cu); grid = -1; return; }
        grid = cus;
        if (grid != 256) { fprintf(stderr, "kernel_launch: this kernel's phase schedules assume 256 CUs (got %d)\n", grid); grid = -1; return; }
        if (grid < MOD_ITEMS) { fprintf(stderr, "kernel_launch: grid %d too small\n", grid); grid = -1; return; }
    }
    if (grid < 0) return;
    Params p{};
    p.x = (const float*)d_in[0]; p.c = (const float*)d_in[1]; p.w_ada = (const float*)d_in[2]; p.b_ada = (const float*)d_in[3]; p.w_in = (const float*)d_in[4];
    p.qg = (const float*)d_in[5]; p.kvg = (const float*)d_in[6]; p.w_uq = (const float*)d_in[7]; p.w_uk = (const float*)d_in[8]; p.w_uv = (const float*)d_in[9];
    p.w_out = (const float*)d_in[10]; p.ln_g = (const float*)d_in[11]; p.ln_b = (const float*)d_in[12];
    p.out = (float*)d_out; p.ws = (unsigned char*)d_ws; p.layer = 0; p.pad = 0;
    void* args[] = {&p};
    hipError_t e = hipLaunchCooperativeKernel((const void*)mega, dim3(grid), dim3(NTHREADS), args, LDS_BYTES, stream);
    if (e != hipSuccess) fprintf(stderr, "kernel_launch: cooperative launch failed: %s (grid %d)\n", hipGetErrorString(e), grid);
}
```
